# Optimizing an MI355X kernel written in HIP

```python
import math
import jax
import jax.numpy as jnp
from jax import lax
import numpy as np

D_MODEL = 1024
BATCH = 16
SEQ = 2048
DEPTH = 4

N_MIXERS = 2
N_ATTN_LAYERS = (DEPTH + N_MIXERS - 1) // N_MIXERS
N_SSM_LAYERS = DEPTH // N_MIXERS

HEAD_DIM = 64
N_Q_HEADS = D_MODEL // HEAD_DIM
N_KV_HEADS = 4
Q_PER_KV = N_Q_HEADS // N_KV_HEADS
WINDOW = 128
ATTN_BLOCK = WINDOW
Q_DIM = N_Q_HEADS * HEAD_DIM
KV_DIM = N_KV_HEADS * HEAD_DIM
QKV_DIM = Q_DIM + 2 * KV_DIM

SSM_GROUP = 16
N_SSM_GROUPS = D_MODEL // SSM_GROUP
SSM_STATE = 64
DT_MIN = 1e-3
DT_MAX = 1e-1

N_EXPERT_GROUPS = 4
EXPERTS_PER_GROUP = 8
N_EXPERTS = N_EXPERT_GROUPS * EXPERTS_PER_GROUP
TOP_K = 2
D_EXPERT = 256
MOE_BLOCK = 128

RMS_EPS = 1e-6
N_ADA = 6

kernel_name = 'hybrid_swa_sink_s5_hmoe'


def rms_norm(x, gain):
    xf = x.astype(jnp.float32)
    xf = xf * lax.rsqrt(jnp.mean(xf * xf, axis=-1, keepdims=True) + RMS_EPS)
    return (xf * gain.astype(jnp.float32)).astype(x.dtype)


def sliding_window_attention(h, w_qkv, q_gain, k_gain, sinks, w_o):
    B, S, D = h.shape
    nb = S // ATTN_BLOCK
    qkv = h @ w_qkv
    q = qkv[..., :Q_DIM].reshape(B, S, N_Q_HEADS, HEAD_DIM)
    k = qkv[..., Q_DIM:Q_DIM + KV_DIM].reshape(B, S, N_KV_HEADS, HEAD_DIM)
    v = qkv[..., Q_DIM + KV_DIM:].reshape(B, S, N_KV_HEADS, HEAD_DIM)
    q = rms_norm(q, q_gain) * (HEAD_DIM ** -0.5)
    k = rms_norm(k, k_gain)
    q = q.reshape(B, nb, ATTN_BLOCK, N_KV_HEADS, Q_PER_KV, HEAD_DIM)

    def with_prev(t):
        t = t.reshape(B, nb, ATTN_BLOCK, N_KV_HEADS, HEAD_DIM)
        prev = jnp.pad(t, ((0, 0), (1, 0), (0, 0), (0, 0), (0, 0)))[:, :-1]
        return jnp.concatenate([prev, t], axis=2)

    kb, vb = with_prev(k), with_prev(v)
    scores = jnp.einsum('bnqhgd,bnshd->bnhgqs', q, kb).astype(jnp.float32)
    qi = jnp.arange(ATTN_BLOCK)[:, None]
    sj = jnp.arange(2 * ATTN_BLOCK)[None, :]
    rel = ATTN_BLOCK + qi - sj
    band = (rel >= 0) & (rel < WINDOW)
    has_prev = (jnp.arange(nb) > 0)[:, None, None]
    valid = band[None] & (has_prev | (sj >= ATTN_BLOCK)[None])
    scores = jnp.where(valid[None, :, None, None], scores, -jnp.inf)
    sink = jnp.broadcast_to(
        sinks.astype(jnp.float32).reshape(1, 1, N_KV_HEADS, Q_PER_KV, 1, 1),
        scores.shape[:-1] + (1,))
    probs = jax.nn.softmax(jnp.concatenate([scores, sink], axis=-1), axis=-1)[..., :-1]
    out = jnp.einsum('bnhgqs,bnshd->bnqhgd', probs.astype(vb.dtype), vb)
    return out.reshape(B, S, Q_DIM) @ w_o


def s5_mixer(h, w_in, lam_re, lam_im, log_dt, b_re, b_im, c_re, c_im, d_skip, w_glu):
    B, S, D = h.shape
    f32 = jnp.float32
    u = (h @ w_in).astype(f32)
    ug = u.reshape(B, S, N_SSM_GROUPS, SSM_GROUP)
    dt = jnp.exp(log_dt.astype(f32))[:, None]
    lr, li = lam_re.astype(f32), lam_im.astype(f32)
    mag = jnp.exp(lr * dt)
    ab_re, ab_im = mag * jnp.cos(li * dt), mag * jnp.sin(li * dt)
    den = lr * lr + li * li
    n_re = ab_re - 1.0
    f_re = (n_re * lr + ab_im * li) / den
    f_im = (ab_im * lr - n_re * li) / den
    br, bi = b_re.astype(f32), b_im.astype(f32)
    bb_re = f_re[..., None] * br - f_im[..., None] * bi
    bb_im = f_re[..., None] * bi + f_im[..., None] * br
    bu_re = jnp.einsum('bsgc,gpc->sbgp', ug, bb_re)
    bu_im = jnp.einsum('bsgc,gpc->sbgp', ug, bb_im)
    a_re = jnp.broadcast_to(ab_re[None, None], (S, 1, N_SSM_GROUPS, SSM_STATE))
    a_im = jnp.broadcast_to(ab_im[None, None], (S, 1, N_SSM_GROUPS, SSM_STATE))

    def combine(left, right):
        al_re, al_im, xl_re, xl_im = left
        ar_re, ar_im, xr_re, xr_im = right
        return (ar_re * al_re - ar_im * al_im,
                ar_re * al_im + ar_im * al_re,
                ar_re * xl_re - ar_im * xl_im + xr_re,
                ar_re * xl_im + ar_im * xl_re + xr_im)

    _, _, xs_re, xs_im = lax.associative_scan(combine, (a_re, a_im, bu_re, bu_im), axis=0)
    y = (jnp.einsum('sbgp,gcp->bsgc', xs_re, c_re.astype(f32))
         - jnp.einsum('sbgp,gcp->bsgc', xs_im, c_im.astype(f32)))
    y = y.reshape(B, S, D) + d_skip.astype(f32) * u
    y = jax.nn.gelu(y).astype(h.dtype)
    z = y @ w_glu
    return z[..., :D] * jax.nn.sigmoid(z[..., D:])


def hierarchical_moe(h, w_group, b_group, w_expert, b_expert, w_gate, w_up, w_down):
    B, S, D = h.shape
    N = B * S
    xt = h.reshape(N, D)
    g_prob = jax.nn.softmax((xt @ w_group).astype(jnp.float32) + b_group.astype(jnp.float32), axis=-1)
    g_w, g_idx = lax.top_k(g_prob, 1)
    e_logits = ((xt @ w_expert).astype(jnp.float32) + b_expert.astype(jnp.float32)
                ).reshape(N, N_EXPERT_GROUPS, EXPERTS_PER_GROUP)
    e_sel = jnp.take_along_axis(e_logits, g_idx[:, :, None], axis=1)[:, 0]
    e_w, e_idx = lax.top_k(jax.nn.softmax(e_sel, axis=-1), TOP_K)
    gates = g_w * (e_w / jnp.sum(e_w, axis=-1, keepdims=True))
    experts = g_idx * EXPERTS_PER_GROUP + e_idx

    A = N * TOP_K
    flat_e = experts.reshape(A).astype(jnp.int32)
    flat_tok = jnp.repeat(jnp.arange(N, dtype=jnp.int32), TOP_K)
    flat_gate = gates.reshape(A)
    order = jnp.argsort(flat_e)
    s_e, s_tok, s_gate = flat_e[order], flat_tok[order], flat_gate[order]
    counts = jnp.zeros((N_EXPERTS,), jnp.int32).at[flat_e].add(1)
    starts = jnp.cumsum(counts) - counts
    padded = (counts + MOE_BLOCK - 1) // MOE_BLOCK * MOE_BLOCK
    pad_ends = jnp.cumsum(padded)
    pad_starts = pad_ends - padded
    dest = pad_starts[s_e] + jnp.arange(A, dtype=jnp.int32) - starts[s_e]
    n_blocks = -(-A // MOE_BLOCK) + N_EXPERTS
    P = n_blocks * MOE_BLOCK
    row_tok = jnp.zeros((P,), jnp.int32).at[dest].set(s_tok)
    row_gate = jnp.zeros((P,), jnp.float32).at[dest].set(s_gate)
    block_start = jnp.arange(n_blocks, dtype=jnp.int32) * MOE_BLOCK
    block_expert = jnp.minimum(jnp.searchsorted(pad_ends, block_start, side='right'),
                               N_EXPERTS - 1)
    xb = xt[row_tok].reshape(n_blocks, MOE_BLOCK, D)

    def expert_block(args):
        xblk, e = args
        hid = jax.nn.silu(xblk @ w_gate[e]) * (xblk @ w_up[e])
        return hid @ w_down[e]

    yb = lax.map(expert_block, (xb, block_expert))
    y_rows = yb.reshape(P, D) * row_gate[:, None].astype(yb.dtype)
    y = jax.ops.segment_sum(y_rows, row_tok, num_segments=N)
    return y.reshape(B, S, D)


def setup_inputs(seed: int = 0) -> dict:
    key = jax.random.key(seed)
    ks = iter(jax.random.split(key, 40))

    def nrm(shape, scale):
        return scale * jax.random.normal(next(ks), shape, jnp.float32)

    L, LA, LS = DEPTH, N_ATTN_LAYERS, N_SSM_LAYERS
    G, P, C = N_SSM_GROUPS, SSM_STATE, SSM_GROUP
    E, F, D = N_EXPERTS, D_EXPERT, D_MODEL
    lam_im = jnp.broadcast_to(math.pi * jnp.arange(P, dtype=jnp.float32), (LS, G, P))
    return {
        'x': nrm((BATCH, SEQ, D), 1.0),
        'c': nrm((BATCH, D), 1.0),
        'norm_mix': 1.0 + nrm((L, D), 0.02),
        'norm_ffn': 1.0 + nrm((L, D), 0.02),
        'w_ada': nrm((L, D, N_ADA * D), 0.5 * D ** -0.5),
        'b_ada': nrm((L, N_ADA * D), 0.02),
        'attn_w_qkv': nrm((LA, D, QKV_DIM), D ** -0.5),
        'attn_q_gain': 1.0 + nrm((LA, HEAD_DIM), 0.02),
        'attn_k_gain': 1.0 + nrm((LA, HEAD_DIM), 0.02),
        'attn_sinks': nrm((LA, N_Q_HEADS), 0.5),
        'attn_w_o': nrm((LA, Q_DIM, D), Q_DIM ** -0.5),
        'ssm_w_in': nrm((LS, D, D), D ** -0.5),
        'ssm_lam_re': -0.5 + nrm((LS, G, P), 0.01),
        'ssm_lam_im': lam_im,
        'ssm_log_dt': jax.random.uniform(next(ks), (LS, G), jnp.float32,
                                         math.log(DT_MIN), math.log(DT_MAX)),
        'ssm_b_re': nrm((LS, G, P, C), (2.0 * C) ** -0.5),
        'ssm_b_im': nrm((LS, G, P, C), (2.0 * C) ** -0.5),
        'ssm_c_re': nrm((LS, G, C, P), (2.0 * P) ** -0.5),
        'ssm_c_im': nrm((LS, G, C, P), (2.0 * P) ** -0.5),
        'ssm_d': nrm((LS, D), 1.0),
        'ssm_w_glu': nrm((LS, D, 2 * D), D ** -0.5),
        'moe_w_group': nrm((L, D, N_EXPERT_GROUPS), D ** -0.5),
        'moe_b_group': nrm((L, N_EXPERT_GROUPS), 0.01),
        'moe_w_expert': nrm((L, D, E), D ** -0.5),
        'moe_b_expert': nrm((L, E), 0.01),
        'moe_w_gate': nrm((L, E, D, F), D ** -0.5),
        'moe_w_up': nrm((L, E, D, F), D ** -0.5),
        'moe_w_down': nrm((L, E, F, D), F ** -0.5),
    }


def reference(x, c, norm_mix, norm_ffn, w_ada, b_ada,
              attn_w_qkv, attn_q_gain, attn_k_gain, attn_sinks, attn_w_o,
              ssm_w_in, ssm_lam_re, ssm_lam_im, ssm_log_dt, ssm_b_re, ssm_b_im,
              ssm_c_re, ssm_c_im, ssm_d, ssm_w_glu,
              moe_w_group, moe_b_group, moe_w_expert, moe_b_expert,
              moe_w_gate, moe_w_up, moe_w_down):
    c_act = jax.nn.silu(c)
    for layer in range(DEPTH):
        ada = (c_act @ w_ada[layer] + b_ada[layer])[:, None, :]
        sh1, sc1, g1, sh2, sc2, g2 = jnp.split(ada, N_ADA, axis=-1)
        h = rms_norm(x, norm_mix[layer]) * (1.0 + sc1) + sh1
        if layer % N_MIXERS == 0:
            i = layer // N_MIXERS
            mix = sliding_window_attention(h, attn_w_qkv[i], attn_q_gain[i], attn_k_gain[i],
                                           attn_sinks[i], attn_w_o[i])
        else:
            i = layer // N_MIXERS
            mix = s5_mixer(h, ssm_w_in[i], ssm_lam_re[i], ssm_lam_im[i], ssm_log_dt[i],
                           ssm_b_re[i], ssm_b_im[i], ssm_c_re[i], ssm_c_im[i],
                           ssm_d[i], ssm_w_glu[i])
        x = x + g1 * mix
        h = rms_norm(x, norm_ffn[layer]) * (1.0 + sc2) + sh2
        x = x + g2 * hierarchical_moe(h, moe_w_group[layer], moe_b_group[layer],
                                      moe_w_expert[layer], moe_b_expert[layer],
                                      moe_w_gate[layer], moe_w_up[layer], moe_w_down[layer])
    return x
```

```cpp
#include <hip/hip_runtime.h>
#include <cstdio>
#include <cstdint>

#define LAS __attribute__((address_space(3)))
#define GAS __attribute__((address_space(1)))
typedef unsigned short bf16_t;
typedef short bf16x8 __attribute__((ext_vector_type(8)));
typedef float f32x4 __attribute__((ext_vector_type(4)));
typedef float f32x2 __attribute__((ext_vector_type(2)));
typedef unsigned u32x4 __attribute__((ext_vector_type(4)));
typedef unsigned u32x2 __attribute__((ext_vector_type(2)));

constexpr int NB = 16, SEQ = 2048, DM = 1024, NTOK = NB * SEQ, DEPTH = 4;
constexpr int HD = 64, NQH = 16, NKVH = 4, QKVD = 1536;
constexpr int SG = 64, SP = 64, SC = 16;
constexpr int NE = 32, FE = 256;
constexpr int ADA = 6 * DM;
constexpr float RMS_EPS = 1e-6f;

constexpr size_t MiB = 1u << 20;
constexpr size_t WS_CTL = 0, CTL_ZERO_BYTES = 1 * MiB;
constexpr size_t WS_ADA = 1 * MiB;
constexpr size_t WS_SSMP = 3 * MiB;
constexpr size_t WS_LIST = 5 * MiB;
constexpr size_t WS_WATT = 13 * MiB;
constexpr size_t WS_WSSM = 23 * MiB;
constexpr size_t WS_SSMM = 35 * MiB;
constexpr size_t WS_WMOE = 75 * MiB;
constexpr size_t WS_R = 267 * MiB;
constexpr size_t WS_D = 459 * MiB;
constexpr size_t WS_XB = 523 * MiB;
constexpr size_t WS_WR = 587 * MiB;
constexpr size_t WS_END = 590 * MiB;
constexpr size_t OUT_H = 0, OUT_HID = 64 * MiB;
constexpr size_t R_Q = 0, R_K = 64 * MiB, R_VT = 80 * MiB;
constexpr size_t R_US = 0, R_W = 96 * MiB, R_YG = 128 * MiB;
constexpr size_t R_Y = 0;

constexpr int CW_TMO = 0, CW_CODE = 1;
constexpr int CW_BAR = 4096;
constexpr int CW_CONV = 8192;
constexpr int CW_GCNT = 16384;

constexpr int LDS_SCR = 147456;
constexpr int RING_BYTES = 131072;
constexpr int MOE_TAB = 131072;
constexpr int N2_TAB = LDS_SCR;
constexpr int MISC_OFF = LDS_SCR + 4096;
constexpr int N2_AB = MISC_OFF + 512;
constexpr int LDS_BYTES = N2_AB + 8192;
constexpr int MAXU = 6;

constexpr int NWAVES = 8;
constexpr bool CONV_IN_TAIL = true;


__device__ __forceinline__ unsigned cvt_pk_bf16(float lo, float hi) { unsigned r; asm volatile("v_cvt_pk_bf16_f32 %0, %1, %2" : "=v"(r) : "v"(lo), "v"(hi)); return r; }
typedef float f32x2p __attribute__((ext_vector_type(2)));
__device__ __forceinline__ unsigned pack4_fp8(float a, float b, float c, float d) { int w = 0; w = __builtin_amdgcn_cvt_pk_fp8_f32(a * 16.0f, b * 16.0f, w, false); w = __builtin_amdgcn_cvt_pk_fp8_f32(c * 16.0f, d * 16.0f, w, true); return (unsigned)w; }
__device__ __forceinline__ f32x4 unpack4_fp8(unsigned w) { const f32x2p lo = __builtin_amdgcn_cvt_pk_f32_fp8((int)w, false), hi = __builtin_amdgcn_cvt_pk_f32_fp8((int)w, true); f32x4 r; r[0] = lo[0]; r[1] = lo[1]; r[2] = hi[0]; r[3] = hi[1]; return r * 0.0625f; }
__device__ __forceinline__ unsigned pack4_fp8_raw(float a, float b, float c, float d) { int w = 0; w = __builtin_amdgcn_cvt_pk_fp8_f32(a, b, w, false); w = __builtin_amdgcn_cvt_pk_fp8_f32(c, d, w, true); return (unsigned)w; }
__device__ __forceinline__ float bf_lo(unsigned w) { return __uint_as_float(w << 16); }
__device__ __forceinline__ float bf_hi(unsigned w) { return __uint_as_float(w & 0xffff0000u); }
template <int M> __device__ __forceinline__ float xor_swz(float v) { return __int_as_float(__builtin_amdgcn_ds_swizzle(__float_as_int(v), (M << 10) | 0x1f)); }
__device__ __forceinline__ float half_sum(float v) {
    const auto r = __builtin_amdgcn_permlane32_swap(__float_as_uint(v), __float_as_uint(v), false, false);
    return __uint_as_float(r[0]) + __uint_as_float(r[1]);
}
__device__ __forceinline__ float wave_sum(float v) { v += xor_swz<1>(v); v += xor_swz<2>(v); v += xor_swz<4>(v); v += xor_swz<8>(v); v += xor_swz<16>(v); return half_sum(v); }
__device__ __forceinline__ float bcast(float v, int srclane) { return __int_as_float(__builtin_amdgcn_readlane(__float_as_int(v), srclane)); }
__device__ __forceinline__ int vzero() { int z = 0; asm volatile("" : "+v"(z)); return z; }
__device__ __forceinline__ float sigmoidf_(float z) { return __builtin_amdgcn_rcpf(1.0f + __builtin_amdgcn_exp2f(-1.4426950408889634f * z)); }
__device__ __forceinline__ float gelu_tanh(float y) { const float z = 0.7978845608028654f * (y + 0.044715f * y * y * y); const float t = 1.0f - 2.0f * __builtin_amdgcn_rcpf(1.0f + __builtin_amdgcn_exp2f(2.885390081777927f * z)); return 0.5f * y * (1.0f + t); }

__device__ __forceinline__ int lane_id();
#define XB_TMO      128
#define XB_XCNT(j)  (256  + 64 * (j))
#define XB_XSUB(j)  (1280 + 64 * (j))
#define XB_XGEN(j)  (2304 + 64 * (j))
#define XB_TOP      3328
#define XB_TOPGEN   3392
#define XCD_BAR_WORDS 3456
#define XB_SPIN_CAP (1u << 18)
typedef GAS unsigned gu32;
__device__ __forceinline__ unsigned xb_ld(gu32* p)              { return __hip_atomic_load(p, __ATOMIC_RELAXED, __HIP_MEMORY_SCOPE_AGENT); }
__device__ __forceinline__ unsigned xb_add(gu32* p, unsigned v) { return __hip_atomic_fetch_add(p, v, __ATOMIC_RELAXED, __HIP_MEMORY_SCOPE_AGENT); }
__device__ __forceinline__ unsigned xb_xcc_id() { return (unsigned)__builtin_amdgcn_s_getreg((3 << 11) | 20) & 0xFu; }
#define XB_SPIN(cond, bar) do { unsigned _sp = 0; while (cond) { __builtin_amdgcn_s_sleep(1); \
    if ((++_sp & 255u) == 0u) { if (xb_ld(&(bar)[XB_TMO])) break; if (_sp > XB_SPIN_CAP) { (void)xb_add(&(bar)[XB_TMO], 1u); break; } } } } while (0)
struct XcdBarrier { gu32* bar; unsigned x; volatile LAS unsigned* st; };
__device__ __forceinline__ XcdBarrier xcd_barrier_post(gu32* bar, volatile LAS unsigned* st) {
    XcdBarrier b; b.bar = bar; b.x = xb_xcc_id(); b.st = st;
    if (threadIdx.x == 0) (void)xb_add(&bar[XB_XCNT(b.x)], 1u);
    return b;
}
__device__ __forceinline__ void xcd_barrier_complete(gu32* bar, unsigned x, unsigned& nloc, unsigned& nx) {
    const unsigned G = gridDim.x * gridDim.y * gridDim.z;
    unsigned sum, cnt, mine, sp = 0u;
    for (;;) {
        sum = 0u; cnt = 0u; mine = 0u;
#pragma unroll
        for (unsigned j = 0; j < 16; ++j) { const unsigned c = xb_ld(&bar[XB_XCNT(j)]); sum += c; cnt += (c > 0u) ? 1u : 0u; mine = (j == x) ? c : mine; }
        if (sum == G) break;
        __builtin_amdgcn_s_sleep(1);
        if ((++sp & 255u) == 0u) { if (xb_ld(&bar[XB_TMO])) break; if (sp > XB_SPIN_CAP) { (void)xb_add(&bar[XB_TMO], 1u); break; } }
    }
    nloc = mine > 0u ? mine : 1u; nx = cnt > 0u ? cnt : 1u;
}
template <bool FIRST>
__device__ __forceinline__ void xcd_barrier(const XcdBarrier& b, const int wave) {
    asm volatile("s_waitcnt vmcnt(0)" ::: "memory");
    __syncthreads();
    if (wave == 0 && lane_id() == 0) {
        gu32* bar = b.bar; unsigned bx = b.x;
        asm volatile("" : "+s"(bar), "+s"(bx));
        __builtin_amdgcn_s_waitcnt(0);
        unsigned nloc = b.st[0], nx = b.st[1];
        if (FIRST) { if (nloc == 0u) { xcd_barrier_complete(bar, bx, nloc, nx); b.st[0] = nloc; b.st[1] = nx; } }
        const unsigned old = xb_add(&bar[XB_XSUB(bx)], 1u);
        const unsigned gen = old / nloc;
        if (old + 1u == (gen + 1u) * nloc) {
            __builtin_amdgcn_fence(__ATOMIC_RELEASE, "agent");
            asm volatile("s_waitcnt vmcnt(0)" ::: "memory");
            const unsigned og = xb_add(&bar[XB_TOP], 1u);
            const unsigned tg = og / nx;
            if (og + 1u == (tg + 1u) * nx) xb_add(&bar[XB_TOPGEN], 1u);
            else XB_SPIN(xb_ld(&bar[XB_TOPGEN]) == tg, bar);
            __builtin_amdgcn_fence(__ATOMIC_ACQUIRE, "agent");
            xb_add(&bar[XB_XGEN(bx)], 1u);
            asm volatile("s_waitcnt vmcnt(0)" ::: "memory");
        } else {
            XB_SPIN(xb_ld(&bar[XB_XGEN(bx)]) == gen, bar);
            __builtin_amdgcn_fence(__ATOMIC_ACQUIRE, "agent");
            asm volatile("s_waitcnt vmcnt(0)" ::: "memory");
        }
    }
    __syncthreads();
}

namespace pg8 {
constexpr int BM = 256, BK = 64, HALF = 128, HTB = HALF * BK * 2, STAGE_BYTES = 8 * HTB, NXCD = 8, WGM = 8;
__host__ __device__ __forceinline__ int lds_byte(int r, int c) { const int st = (r >> 4) * 2 + (c >> 5), rr = r & 15, cc = c & 31, ob = rr * 64 + cc * 2; return st * 1024 + (ob ^ (((ob >> 9) & 1) << 5)); }
__host__ __device__ __forceinline__ void stage_rc(int b, int& R, int& C) { const int st = b / 1024, sb = b % 1024, swz = sb ^ (((sb >> 9) & 1) << 5); R = (st >> 1) * 16 + swz / 64; C = (st & 1) * 32 + (swz % 64) / 2; }
__host__ __device__ __forceinline__ int perm32(int rho) { const int n = rho >> 4, i = rho & 15; return 8 * (i >> 2) + 4 * n + (i & 3); }

struct Unit { int pm, pn, ui; const bf16_t* A; const bf16_t* Bt; };

template <class Epi, class Sched, bool GATHER, bool ALIGN_EPI, bool FP8 = false>
__device__ __forceinline__ void gemm_phase(LAS unsigned char* lds, const int wid, const int K, const int lda, const Sched& S, const Epi& E, volatile LAS const unsigned* gtab) {
    int lane = lane_id(); asm volatile("" : "+v"(lane));
    const int tid = wid * 64 + lane, wr = wid >> 2, wc = wid & 3, fr = lane & 15, fq = lane >> 4;
    const int nt = K / BK;
    unsigned voffA[2], voffB[2]; int Rr[2];
#pragma unroll
    for (int i = 0; i < 2; ++i) { int R, C; stage_rc(tid * 16 + i * 8192, R, C); const int Rb = Epi::PERM ? ((R & ~31) + perm32(R & 31)) : R;
        Rr[i] = R; voffA[i] = GATHER ? 0u : (unsigned)(R * lda + C) * 2u; voffB[i] = (unsigned)(Rb * K + C) * 2u; }
    const size_t hstepB = (size_t)HALF * K * 2, hstepA = (size_t)HALF * lda * 2;
    const unsigned rowb = (unsigned)lda * 2u;
    const unsigned ldsw = (unsigned)wid * 1024u;
    const int aoff = lds_byte(wr * 64 + fr, fq * 8), boff = lds_byte(wc * 32 + fr, fq * 8);
#define PG8_SA(b, h) (((b) * 2 + (h)) * HTB)
#define PG8_SB(b, h) ((4 + (b) * 2 + (h)) * HTB)
#define PG8_STAGE(bufoff, gbase, voff) do { _Pragma("unroll") for (int _i = 0; _i < 2; ++_i) \
        __builtin_amdgcn_global_load_lds((const unsigned*)((const char*)(gbase) + (voff)[_i]), (LAS unsigned*)(lds + (bufoff) + ldsw + _i * 8192), 16, 0, 0); } while (0)
#define PG8_GTOK(dst, uidx, half) do { if constexpr (GATHER) { _Pragma("unroll") for (int _i = 0; _i < 2; ++_i) { int R_, C_, t_ = tid; asm volatile("" : "+v"(t_)); stage_rc(t_ * 16 + _i * 8192, R_, C_);     \
        dst[_i] = gtab[(uidx) * 256 + (half) * 128 + R_] * rowb + (unsigned)C_ * 2u; } } } while (0)
#define PG8_LDA(dst, b, h) do { if constexpr (FP8) { _Pragma("unroll") for (int m = 0; m < 4; ++m) dst##8[m] = __builtin_shufflevector(*(const LAS v4i_*)(lds + PG8_SA(b, h) + aoff + m * 2048), *(const LAS v4i_*)(lds + PG8_SA(b, h) + aoff + m * 2048 + 1024), 0, 1, 2, 3, 4, 5, 6, 7); } \
        else { _Pragma("unroll") for (int m = 0; m < 4; ++m) _Pragma("unroll") for (int k = 0; k < 2; ++k) dst[m][k] = *(const LAS bf16x8*)(lds + PG8_SA(b, h) + aoff + m * 2048 + k * 1024); } } while (0)
#define PG8_LDB(dst, b, h) do { if constexpr (FP8) { _Pragma("unroll") for (int n = 0; n < 2; ++n) dst##8[n] = __builtin_shufflevector(*(const LAS v4i_*)(lds + PG8_SB(b, h) + boff + n * 2048), *(const LAS v4i_*)(lds + PG8_SB(b, h) + boff + n * 2048 + 1024), 0, 1, 2, 3, 4, 5, 6, 7); } \
        else { _Pragma("unroll") for (int n = 0; n < 2; ++n) _Pragma("unroll") for (int k = 0; k < 2; ++k) dst[n][k] = *(const LAS bf16x8*)(lds + PG8_SB(b, h) + boff + n * 2048 + k * 1024); } } while (0)
#define PG8_MMA(ai, bj, At, Bt) do { __builtin_amdgcn_s_setprio(1); _Pragma("unroll") for (int m = 0; m < 4; ++m) _Pragma("unroll") for (int n = 0; n < 2; ++n) { \
        if constexpr (FP8) acc[ai][bj][m][n] = __builtin_amdgcn_mfma_scale_f32_16x16x128_f8f6f4(Bt##8[n], At##8[m], acc[ai][bj][m][n], 0, 0, 0, 0x7f7f7f7f, 0, 0x7f7f7f7f); \
        else { _Pragma("unroll") for (int k = 0; k < 2; ++k) acc[ai][bj][m][n] = __builtin_amdgcn_mfma_f32_16x16x32_bf16(Bt[n][k], At[m][k], acc[ai][bj][m][n], 0, 0, 0); } } \
        __builtin_amdgcn_s_setprio(0); } while (0)
#define PG8_WAIT_V(n) asm volatile("s_waitcnt vmcnt(" #n ")" ::: "memory")
#define PG8_WAIT_L(n) asm volatile("s_waitcnt lgkmcnt(" #n ")" ::: "memory")
#define PG8_BAR __builtin_amdgcn_s_barrier()
#define PG8_SCHED __builtin_amdgcn_sched_barrier(0)
    Unit cur, nxt; int ui = 0;
    if (!S.next(0, cur)) return;
    f32x4 acc[2][2][4][2];
#pragma unroll
    for (int a = 0; a < 2; ++a)
#pragma unroll
        for (int b = 0; b < 2; ++b)
#pragma unroll
            for (int m = 0; m < 4; ++m)
#pragma unroll
                for (int n = 0; n < 2; ++n) acc[a][b][m][n] = (f32x4){0.f, 0.f, 0.f, 0.f};
    typedef int v4i_ __attribute__((ext_vector_type(4))); typedef int v8i_ __attribute__((ext_vector_type(8)));
    bf16x8 At[4][2], B0[2][2], B1[2][2];
    v8i_ At8[4], B08[2], B18[2];
    unsigned go[2];
    const char* cA = (const char*)cur.A; const char* cB = (const char*)cur.Bt;
    PG8_STAGE(PG8_SB(0, 0), cB, voffB); PG8_STAGE(PG8_SB(0, 1), cB + hstepB, voffB);
    if constexpr (GATHER) { PG8_GTOK(go, 0, 0); PG8_STAGE(PG8_SA(0, 0), cA, go); PG8_GTOK(go, 0, 1); PG8_STAGE(PG8_SA(0, 1), cA, go); }
    else { PG8_STAGE(PG8_SA(0, 0), cA, voffA); PG8_STAGE(PG8_SA(0, 1), cA + hstepA, voffA); }
    if (wr == 1) PG8_BAR;
    PG8_WAIT_V(2); PG8_BAR;
    PG8_STAGE(PG8_SB(1, 0), cB + 128, voffB);
    if constexpr (GATHER) { PG8_GTOK(go, 0, 0); PG8_STAGE(PG8_SA(1, 0), cA + 128, go); } else { PG8_STAGE(PG8_SA(1, 0), cA + 128, voffA); }
    PG8_STAGE(PG8_SB(1, 1), cB + hstepB + 128, voffB);
    PG8_WAIT_V(6); PG8_BAR;
    for (;;) {
        const bool has_next = S.next(ui + 1, nxt);
        const char* nA = has_next ? (const char*)nxt.A : cA; const char* nB = has_next ? (const char*)nxt.Bt : cB;
        const int nui = has_next ? ui + 1 : ui;
#pragma nounroll
        for (int t = 0; t < nt; t += 2) {
            const bool last = (t == nt - 2);
            const char* a1 = cA + (size_t)(t + 1) * 128;
            const char* a2 = last ? nA : cA + (size_t)(t + 2) * 128; const char* b2 = last ? nB : cB + (size_t)(t + 2) * 128;
            const char* a3 = a2 + 128; const char* b3 = b2 + 128;
            const int u2 = last ? nui : ui;
            PG8_GTOK(go, ui, 1);
            PG8_LDB(B0, 0, 0); PG8_LDB(B1, 0, 1); PG8_SCHED; PG8_LDA(At, 0, 0);
            if constexpr (GATHER) { PG8_STAGE(PG8_SA(1, 1), a1, go); } else { PG8_STAGE(PG8_SA(1, 1), a1 + hstepA, voffA); }
            PG8_WAIT_V(8); PG8_WAIT_L(0); PG8_BAR; PG8_MMA(0, 0, At, B0); PG8_MMA(0, 1, At, B1); PG8_BAR; PG8_SCHED;
            PG8_GTOK(go, u2, 0);
            PG8_LDA(At, 0, 1); PG8_STAGE(PG8_SB(0, 0), b2, voffB); PG8_STAGE(PG8_SB(0, 1), b2 + hstepB, voffB);
            if constexpr (GATHER) { PG8_STAGE(PG8_SA(0, 0), a2, go); } else { PG8_STAGE(PG8_SA(0, 0), a2, voffA); }
            PG8_WAIT_V(8); PG8_WAIT_L(0); PG8_BAR; PG8_MMA(1, 0, At, B0); PG8_MMA(1, 1, At, B1); PG8_BAR; PG8_SCHED;
            PG8_GTOK(go, u2, 1);
            PG8_LDB(B0, 1, 0); PG8_LDB(B1, 1, 1); PG8_SCHED; PG8_LDA(At, 1, 0);
            if constexpr (GATHER) { PG8_STAGE(PG8_SA(0, 1), a2, go); } else { PG8_STAGE(PG8_SA(0, 1), a2 + hstepA, voffA); }
            PG8_WAIT_V(8); PG8_WAIT_L(0); PG8_BAR; PG8_MMA(0, 0, At, B0); PG8_MMA(0, 1, At, B1); PG8_BAR; PG8_SCHED;
            PG8_GTOK(go, u2, 0);
            PG8_LDA(At, 1, 1); PG8_STAGE(PG8_SB(1, 0), b3, voffB); PG8_STAGE(PG8_SB(1, 1), b3 + hstepB, voffB);
            if constexpr (GATHER) { PG8_STAGE(PG8_SA(1, 0), a3, go); } else { PG8_STAGE(PG8_SA(1, 0), a3, voffA); }
            PG8_WAIT_V(8); PG8_WAIT_L(0); PG8_BAR; PG8_MMA(1, 0, At, B0); PG8_MMA(1, 1, At, B1); PG8_BAR; PG8_SCHED;
        }
        if constexpr (ALIGN_EPI) { if (wr == 0) PG8_BAR; }
        E(acc, cur, wr, wc, fr, fq, lds);
        if (!has_next) break;
#pragma unroll
        for (int a = 0; a < 2; ++a)
#pragma unroll
            for (int b = 0; b < 2; ++b)
#pragma unroll
                for (int m = 0; m < 4; ++m)
#pragma unroll
                    for (int n = 0; n < 2; ++n) acc[a][b][m][n] = (f32x4){0.f, 0.f, 0.f, 0.f};
        cur = nxt; cA = nA; cB = nB; ++ui;
        if constexpr (ALIGN_EPI) { if (wr == 1) PG8_BAR; }
    }
    PG8_WAIT_V(0);
    if constexpr (!ALIGN_EPI) { if (wr == 0) PG8_BAR; }
    PG8_BAR;
#undef PG8_SA
#undef PG8_SB
#undef PG8_STAGE
#undef PG8_GTOK
#undef PG8_LDA
#undef PG8_LDB
#undef PG8_MMA
#undef PG8_WAIT_V
#undef PG8_WAIT_L
#undef PG8_BAR
#undef PG8_SCHED
}

struct DenseOrder {
    int nM, nN, nwg, G, c, K, lda; const bf16_t* A; const bf16_t* Bt; bool via_table = false;
    __device__ __forceinline__ void init(int M, int N, int K_, int lda_, int G_, int c_, const bf16_t* A_, const bf16_t* Bt_) { nM = M / BM; nN = N / BM; nwg = nM * nN; G = G_; c = c_; K = K_; lda = lda_; A = A_; Bt = Bt_; }
    __device__ __forceinline__ bool next(int i, Unit& u) const {
        const long L = (long)i * G + c; if (L >= nwg) return false;
        int wgid = (int)L; { const int q = nwg / NXCD, r = nwg % NXCD, xcd = wgid % NXCD, off = wgid / NXCD; wgid = (xcd < r ? xcd * (q + 1) : r * (q + 1) + (xcd - r) * q) + off; }
        const int nig = WGM * nN, gid = wgid / nig, fm = gid * WGM, gsz = (nM - fm) < WGM ? (nM - fm) : WGM;
        u.pm = fm + ((wgid % nig) % gsz); u.pn = (wgid % nig) / gsz; u.ui = i; u.A = via_table ? A : A + (size_t)u.pm * BM * lda; u.Bt = Bt + (size_t)u.pn * BM * K; return true;
    }
};
}

struct Params {
    const float* x; const float* c; const float* norm_mix; const float* norm_ffn; const float* w_ada; const float* b_ada;
    const float* attn_w_qkv; const float* attn_q_gain; const float* attn_k_gain; const float* attn_sinks; const float* attn_w_o;
    const float* ssm_w_in; const float* ssm_lam_re; const float* ssm_lam_im; const float* ssm_log_dt; const float* ssm_b_re; const float* ssm_b_im;
    const float* ssm_c_re; const float* ssm_c_im; const float* ssm_d; const float* ssm_w_glu;
    const float* moe_w_group; const float* moe_b_group; const float* moe_w_expert; const float* moe_b_expert;
    const float* moe_w_gate; const float* moe_w_up; const float* moe_w_down;
    float* out; unsigned char* ws;
};

__device__ __forceinline__ Params load_params() {
    Params p{};
#if defined(__HIP_DEVICE_COMPILE__)
    typedef GAS char* gptr_t;
    typedef __attribute__((address_space(4))) const gptr_t* KP;
    KP kp = (KP)__builtin_amdgcn_kernarg_segment_ptr();
    asm volatile("" : "+s"(kp));
    p.x = (const float*)kp[0]; p.c = (const float*)kp[1]; p.norm_mix = (const float*)kp[2]; p.norm_ffn = (const float*)kp[3]; p.w_ada = (const float*)kp[4]; p.b_ada = (const float*)kp[5];
    p.attn_w_qkv = (const float*)kp[6]; p.attn_q_gain = (const float*)kp[7]; p.attn_k_gain = (const float*)kp[8]; p.attn_sinks = (const float*)kp[9]; p.attn_w_o = (const float*)kp[10];
    p.ssm_w_in = (const float*)kp[11]; p.ssm_lam_re = (const float*)kp[12]; p.ssm_lam_im = (const float*)kp[13]; p.ssm_log_dt = (const float*)kp[14]; p.ssm_b_re = (const float*)kp[15]; p.ssm_b_im = (const float*)kp[16];
    p.ssm_c_re = (const float*)kp[17]; p.ssm_c_im = (const float*)kp[18]; p.ssm_d = (const float*)kp[19]; p.ssm_w_glu = (const float*)kp[20];
    p.moe_w_group = (const float*)kp[21]; p.moe_b_group = (const float*)kp[22]; p.moe_w_expert = (const float*)kp[23]; p.moe_b_expert = (const float*)kp[24];
    p.moe_w_gate = (const float*)kp[25]; p.moe_w_up = (const float*)kp[26]; p.moe_w_down = (const float*)kp[27];
    p.out = (float*)kp[28]; p.ws = (unsigned char*)kp[29];
#endif
    return p;
}
__device__ __forceinline__ int opaque_v(int v) { asm volatile("" : "+v"(v)); return v; }
__device__ __forceinline__ int lane_id() { int l; asm volatile("v_mbcnt_lo_u32_b32 %0, -1, 0\n\tv_mbcnt_hi_u32_b32 %0, -1, %0" : "=v"(l)); return l; }

using pg8::Unit;
typedef f32x4 AccT[2][2][4][2];

struct EpiQKV {
    static constexpr bool PERM = true;
    bf16_t* Q; bf16_t* Kb; bf16_t* Vt;
    __device__ __forceinline__ void operator()(const AccT& acc, const Unit& u, int wr, int wc, int fr, int fq, LAS unsigned char*) const {
        const int row0 = u.pm * 256 + wr * 64 + fr, cl = wc * 32 + 8 * fq;
#pragma unroll
        for (int ai = 0; ai < 2; ++ai)
#pragma unroll
            for (int m = 0; m < 4; ++m) {
                const int row = row0 + ai * 128 + m * 16;
#pragma unroll
                for (int bj = 0; bj < 2; ++bj) {
                    const f32x4 v0 = acc[ai][bj][m][0], v1 = acc[ai][bj][m][1];
                    u32x4 w; w.x = cvt_pk_bf16(v0[0], v0[1]); w.y = cvt_pk_bf16(v0[2], v0[3]); w.z = cvt_pk_bf16(v1[0], v1[1]); w.w = cvt_pk_bf16(v1[2], v1[3]);
                    const int col = bj * 128 + cl;
                    if (u.pn < 4) { *(u32x4*)((char*)Q + (unsigned)(row * 1024 + u.pn * 256 + col) * 2u) = w; }
                    else if (u.pn == 4) { *(u32x4*)((char*)Kb + (unsigned)(row * 256 + col) * 2u) = w; }
                    else {
                        const int b = row >> 11, t0 = row & 2047, t = (t0 & ~31) | ((((t0 >> 2) & 1) << 4) + (((t0 >> 3) & 3) << 2) + (t0 & 3)), kvh = col >> 6, d0 = col & 63;
                        bf16_t* vp = (bf16_t*)((char*)Vt + (unsigned)((((b * 4 + kvh) * 64 + d0)) * 2048 + t) * 2u);
                        vp[0 * 2048] = (bf16_t)(w.x & 0xffffu); vp[1 * 2048] = (bf16_t)(w.x >> 16);
                        vp[2 * 2048] = (bf16_t)(w.y & 0xffffu); vp[3 * 2048] = (bf16_t)(w.y >> 16);
                        vp[4 * 2048] = (bf16_t)(w.z & 0xffffu); vp[5 * 2048] = (bf16_t)(w.z >> 16);
                        vp[6 * 2048] = (bf16_t)(w.w & 0xffffu); vp[7 * 2048] = (bf16_t)(w.w >> 16);
                    }
                }
            }
    }
};
struct EpiDelta {
    static constexpr bool PERM = true;
    bf16_t* D; const float* gate_l;
    __device__ __forceinline__ void operator()(const AccT& acc, const Unit& u, int wr, int wc, int fr, int fq, LAS unsigned char*) const {
        const int row0 = u.pm * 256 + wr * 64 + fr, col0 = u.pn * 256 + wc * 32 + 8 * fq;
        const float* gp = (const float*)((const char*)gate_l + (unsigned)((u.pm >> 3) * ADA + col0) * 4u);
        f32x4 gv[2][2];
#pragma unroll
        for (int bj = 0; bj < 2; ++bj)
#pragma unroll
            for (int n = 0; n < 2; ++n) gv[bj][n] = *(const f32x4*)(gp + bj * 128 + n * 4);
        u32x4 xo[2][4][2];
#pragma unroll
        for (int ai = 0; ai < 2; ++ai)
#pragma unroll
            for (int m = 0; m < 4; ++m) { const bf16_t* rowp = (const bf16_t*)((const char*)D + (unsigned)((row0 + ai * 128 + m * 16) * 1024 + col0) * 2u);
#pragma unroll
                for (int bj = 0; bj < 2; ++bj) xo[ai][m][bj] = *(const u32x4*)(rowp + bj * 128); }
#pragma unroll
        for (int ai = 0; ai < 2; ++ai)
#pragma unroll
            for (int m = 0; m < 4; ++m) { bf16_t* rowp = (bf16_t*)((char*)D + (unsigned)((row0 + ai * 128 + m * 16) * 1024 + col0) * 2u);
#pragma unroll
                for (int bj = 0; bj < 2; ++bj) { const f32x4 v0 = acc[ai][bj][m][0] * gv[bj][0], v1 = acc[ai][bj][m][1] * gv[bj][1]; const u32x4 x = xo[ai][m][bj];
                    u32x4 w; w.x = cvt_pk_bf16(bf_lo(x.x) + v0[0], bf_hi(x.x) + v0[1]); w.y = cvt_pk_bf16(bf_lo(x.y) + v0[2], bf_hi(x.y) + v0[3]);
                    w.z = cvt_pk_bf16(bf_lo(x.z) + v1[0], bf_hi(x.z) + v1[1]); w.w = cvt_pk_bf16(bf_lo(x.w) + v1[2], bf_hi(x.w) + v1[3]);
                    *(u32x4*)(rowp + bj * 128) = w; } }
    }
};
struct EpiGLU {
    static constexpr bool PERM = true;
    bf16_t* D; const float* gate_l;
    __device__ __forceinline__ void operator()(const AccT& acc, const Unit& u, int wr, int wc, int fr, int fq, LAS unsigned char*) const {
        int pm_ = u.pm; asm volatile("" : "+s"(pm_));
        const int row0 = pm_ * 256 + wr * 64 + fr, col0 = u.pn * 128 + wc * 32 + 8 * fq;
        const float* gp = (const float*)((const char*)gate_l + (unsigned)((pm_ >> 3) * ADA + col0) * 4u);
        f32x4 gv[2];
#pragma unroll
        for (int n = 0; n < 2; ++n) gv[n] = *(const f32x4*)(gp + n * 4);
        u32x4 xo[2][4];
#pragma unroll
        for (int ai = 0; ai < 2; ++ai)
#pragma unroll
            for (int m = 0; m < 4; ++m) xo[ai][m] = *(const u32x4*)((const char*)D + (unsigned)((row0 + ai * 128 + m * 16) * 1024 + col0) * 2u);
#pragma unroll
        for (int ai = 0; ai < 2; ++ai)
#pragma unroll
            for (int m = 0; m < 4; ++m) { float o[8];
#pragma unroll
                for (int n = 0; n < 2; ++n)
#pragma unroll
                    for (int j = 0; j < 4; ++j) o[n * 4 + j] = gv[n][j] * (acc[ai][0][m][n][j] * 0.0625f) * sigmoidf_(acc[ai][1][m][n][j] * 0.0625f);
                const u32x4 x = xo[ai][m];
                u32x4 w; w.x = cvt_pk_bf16(bf_lo(x.x) + o[0], bf_hi(x.x) + o[1]); w.y = cvt_pk_bf16(bf_lo(x.y) + o[2], bf_hi(x.y) + o[3]);
                w.z = cvt_pk_bf16(bf_lo(x.z) + o[4], bf_hi(x.z) + o[5]); w.w = cvt_pk_bf16(bf_lo(x.w) + o[6], bf_hi(x.w) + o[7]);
                *(u32x4*)((char*)D + (unsigned)((row0 + ai * 128 + m * 16) * 1024 + col0) * 2u) = w; }
    }
};
struct EpiU {
    static constexpr bool PERM = true;
    bf16_t* US;
    __device__ __forceinline__ void operator()(const AccT& acc, const Unit& u, int wr, int wc, int fr, int fq, LAS unsigned char*) const {
        const int row0 = u.pm * 256 + wr * 64 + fr;
#pragma unroll
        for (int ai = 0; ai < 2; ++ai)
#pragma unroll
            for (int m = 0; m < 4; ++m) {
                const int row = row0 + ai * 128 + m * 16, b = row >> 11, t = row & 2047;
#pragma unroll
                for (int bj = 0; bj < 2; ++bj) {
                    const f32x4 v0 = acc[ai][bj][m][0] * 0.0625f, v1 = acc[ai][bj][m][1] * 0.0625f;
                    u32x4 w; w.x = cvt_pk_bf16(v0[0], v0[1]); w.y = cvt_pk_bf16(v0[2], v0[3]); w.z = cvt_pk_bf16(v1[0], v1[1]); w.w = cvt_pk_bf16(v1[2], v1[3]);
                    const int c0 = u.pn * 256 + bj * 128 + wc * 32 + 8 * fq, g = c0 >> 4, ci0 = c0 & 15;
                    *(u32x4*)((char*)US + (unsigned)((g * 2048 + b * 128 + (t >> 4)) * 384 + (t & 15) * 16 + ci0) * 2u) = w;
                }
            }
    }
};
struct EpiSwiGLU {
    static constexpr bool PERM = true;
    bf16_t* HID;
    __device__ __forceinline__ void operator()(const AccT& acc, const Unit& u, int wr, int wc, int fr, int fq, LAS unsigned char*) const {
        const int row0 = u.pm * 256 + wr * 64 + fr, col0 = u.pn * 128 + wc * 32 + 8 * fq;
#pragma unroll
        for (int ai = 0; ai < 2; ++ai)
#pragma unroll
            for (int m = 0; m < 4; ++m) {
                float h[8];
#pragma unroll
                for (int n = 0; n < 2; ++n)
#pragma unroll
                    for (int j = 0; j < 4; ++j) { const float g = acc[ai][0][m][n][j] * 0.0625f, up = acc[ai][1][m][n][j] * 0.0625f; h[n * 4 + j] = g * sigmoidf_(g) * up; }
                u32x2 w; w.x = pack4_fp8_raw(h[0] * 8.f, h[1] * 8.f, h[2] * 8.f, h[3] * 8.f); w.y = pack4_fp8_raw(h[4] * 8.f, h[5] * 8.f, h[6] * 8.f, h[7] * 8.f);
                *(u32x2*)((unsigned char*)HID + (unsigned)((row0 + ai * 128 + m * 16) * 256 + col0)) = w;
            }
    }
};
struct EpiDown {
    static constexpr bool PERM = true;
    bf16_t* Y;
    __device__ __forceinline__ void operator()(const AccT& acc, const Unit& u, int wr, int wc, int fr, int fq, LAS unsigned char* lds) const {
        volatile LAS const unsigned* tab = (volatile LAS const unsigned*)(lds + MOE_TAB + 256) + u.ui * 512;
        const int col0 = u.pn * 256 + wc * 32 + 8 * fq;
#pragma unroll
        for (int ai = 0; ai < 2; ++ai)
#pragma unroll
            for (int m = 0; m < 4; ++m) {
                const int ti = (ai * 128 + wr * 64 + m * 16 + fr) * 2;
                u32x2 ent; ent.x = tab[ti]; ent.y = tab[ti + 1];
                if (ent.x != 0xffffffffu) {
                    const float gate = __uint_as_float(ent.y) * (1.0f / 128.0f);
                    unsigned char* dst = (unsigned char*)Y + (((ent.x & 1u) * (unsigned)NTOK + (ent.x >> 1)) * 1024u + (unsigned)col0);
#pragma unroll
                    for (int bj = 0; bj < 2; ++bj) {
                        const f32x4 v0 = acc[ai][bj][m][0] * gate, v1 = acc[ai][bj][m][1] * gate;
                        u32x2 w; w.x = pack4_fp8(v0[0], v0[1], v0[2], v0[3]); w.y = pack4_fp8(v1[0], v1[1], v1[2], v1[3]);
                        *(u32x2*)(dst + bj * 128) = w;
                    }
                }
            }
    }
};

struct SsmOrder {
    int G, c, K; const bf16_t* US; const bf16_t* Bm; size_t bstride;
    __device__ __forceinline__ bool next(int i, Unit& u) const {
        const int L = i * G + c; if (L >= SG * 8) return false;
        u.pm = L; u.pn = 0; u.ui = i; u.A = US + (size_t)L * 256 * 384; u.Bt = Bm + (size_t)(L >> 3) * bstride; return true;
    }
};
struct EpiW {
    static constexpr bool PERM = true;
    bf16_t* W;
    __device__ __forceinline__ void operator()(const AccT& acc, const Unit& u, int wr, int wc, int fr, int fq, LAS unsigned char*) const {
        const int row0 = u.pm * 256 + wr * 64 + fr, col0 = wc * 32 + 8 * fq;
#pragma unroll
        for (int ai = 0; ai < 2; ++ai)
#pragma unroll
            for (int m = 0; m < 4; ++m) { const f32x4 v0 = acc[ai][0][m][0], v1 = acc[ai][0][m][1];
                u32x4 w; w.x = cvt_pk_bf16(v0[0], v0[1]); w.y = cvt_pk_bf16(v0[2], v0[3]); w.z = cvt_pk_bf16(v1[0], v1[1]); w.w = cvt_pk_bf16(v1[2], v1[3]);
                *(u32x4*)((char*)W + (unsigned)((row0 + ai * 128 + m * 16) * 128 + col0) * 2u) = w; }
    }
};
struct EpiY {
    static constexpr bool PERM = true;
    bf16_t* YG;
    __device__ __forceinline__ void operator()(const AccT& acc, const Unit& u, int wr, int wc, int fr, int fq, LAS unsigned char*) const {
        const int g = u.pm >> 3, rowg0 = (u.pm & 7) * 256 + wr * 64 + fr;
#pragma unroll
        for (int ai = 0; ai < 2; ++ai)
#pragma unroll
            for (int m = 0; m < 4; ++m) {
                const int rowg = rowg0 + ai * 128 + m * 16, b = rowg >> 7, k = rowg & 127;
#pragma unroll
                for (int bj = 0; bj < 2; ++bj) {
                    const f32x4 v0 = acc[ai][bj][m][0], v1 = acc[ai][bj][m][1];
                    u32x2 w; w.x = pack4_fp8_raw(gelu_tanh(v0[0]), gelu_tanh(v0[1]), gelu_tanh(v0[2]), gelu_tanh(v0[3])); w.y = pack4_fp8_raw(gelu_tanh(v1[0]), gelu_tanh(v1[1]), gelu_tanh(v1[2]), gelu_tanh(v1[3]));
                    const int col = bj * 128 + wc * 32 + 8 * fq, t = col >> 4, co0 = col & 15;
                    *(u32x2*)((unsigned char*)YG + (unsigned)((b * 2048 + 16 * k + t) * 1024 + g * 16 + co0)) = w;
                }
            }
    }
};

struct MoeOrder {
    LAS const int* utab; int nunits, K, dense_lda; const bf16_t* A; const bf16_t* Wl; size_t boff;
    __device__ __forceinline__ bool next(int i, Unit& u) const {
        if (i >= nunits) return false;
        const LAS int* t = utab + i * 8;
        u.pm = __builtin_amdgcn_readfirstlane(t[0]); u.pn = __builtin_amdgcn_readfirstlane(t[1]); const int e = __builtin_amdgcn_readfirstlane(t[2]); u.ui = i;
        u.A = A + (size_t)u.pm * 256 * dense_lda; u.Bt = Wl + (size_t)e * 786432 + boff + (size_t)u.pn * 256 * K; return true;
    }
};

struct Ctx { LAS unsigned char* lds; int wave, vcu, G, gw, NGW; };

constexpr int CI_QKV = 16 * 6, CI_SQ = 16 * 4, CI_GLU = 16 * 8, CI_ATT = CI_QKV + CI_SQ, CI_SSM = CI_SQ + CI_GLU, CI_EXP = 48;
constexpr int CI_DENSE = 2 * CI_ATT + 2 * CI_SSM;
__device__ __forceinline__ void conv_range(const Params& p, const Ctx& cx, const int tid_, const int cbeg, const int cend) {
    f32x4 preA[8], preB[8];
    const float* srcA = nullptr; bf16_t* dstA = nullptr; int KA = 0, NA = 0, k0A = 0, n0A = 0, modeA = 0;
    const float* srcB = nullptr; bf16_t* dstB = nullptr; int KB = 0, NB_ = 0, k0B = 0, n0B = 0, modeB = 0;
#define CV_DECODE(it_, src, dst, K, N, k0, n0, mode) do { int r = (it_); \
        if (r < 2 * CI_ATT) { const int i = r / CI_ATT; int q = r % CI_ATT; bf16_t* base = (bf16_t*)(p.ws + WS_WATT + (size_t)i * 5 * MiB); \
            if (q < CI_QKV) { src = p.attn_w_qkv + (size_t)i * DM * QKVD; dst = base; K = DM; N = QKVD; k0 = (q / 6) * 64; n0 = (q % 6) * 256; mode = 0; } \
            else { q -= CI_QKV; src = p.attn_w_o + (size_t)i * DM * DM; dst = base + 3 * MiB / 2; K = DM; N = DM; k0 = (q / 4) * 64; n0 = (q % 4) * 256; mode = 0; } } \
        else if ((r -= 2 * CI_ATT) < 2 * CI_SSM) { const int i = r / CI_SSM; int q = r % CI_SSM; bf16_t* base = (bf16_t*)(p.ws + WS_WSSM + (size_t)i * 6 * MiB); \
            if (q < CI_SQ) { src = p.ssm_w_in + (size_t)i * DM * DM; dst = base; K = DM; N = DM; k0 = (q / 4) * 64; n0 = (q % 4) * 256; mode = 4; } \
            else { q -= CI_SQ; src = p.ssm_w_glu + (size_t)i * DM * 2 * DM; dst = base + 2 * MiB / 2; K = DM; N = 2 * DM; k0 = (q / 8) * 64; n0 = (q % 8) * 256; mode = 1; } } \
        else { r -= 2 * CI_SSM; const int le = r / CI_EXP, q = r % CI_EXP, which = q >> 4, sub = q & 15; bf16_t* base = (bf16_t*)(p.ws + WS_WMOE + (size_t)le * 3 * MiB / 2); \
            if (which < 2) { src = (which ? p.moe_w_up : p.moe_w_gate) + (size_t)le * DM * FE; dst = base; K = DM; N = FE; k0 = sub * 64; n0 = 0; mode = 2 + which; } \
            else { src = p.moe_w_down + (size_t)le * FE * DM; dst = base + MiB / 2; K = FE; N = DM; k0 = (sub >> 2) * 64; n0 = (sub & 3) * 256; mode = 5; } } } while (0)
#define CV_LOAD(pre, src, N, k0, n0) do { _Pragma("unroll") for (int i_ = 0; i_ < 8; ++i_) { const int idx = tid_ + 512 * i_; pre[i_] = *(const f32x4*)(src + (size_t)(k0 + (idx >> 6)) * N + n0 + 4 * (idx & 63)); } } while (0)
#define CV_ITEM(pre, src, dst, K, N, k0, n0, mode, bufi, nxt_) do { \
        LAS float* Lt = (LAS float*)(cx.lds + (bufi) * 66560); \
        _Pragma("unroll") for (int i_ = 0; i_ < 8; ++i_) { const int idx = tid_ + 512 * i_; *(LAS f32x4*)(Lt + (idx >> 6) * 260 + 4 * (idx & 63)) = pre[i_]; } \
        bf16_t* cdst = dst; const int cK = K, ck0 = k0, cn0 = n0, cmode = mode; \
        __syncthreads(); \
        if ((nxt_) < cend) { CV_DECODE((nxt_), src, dst, K, N, k0, n0, mode); CV_LOAD(pre, src, N, k0, n0); } \
        _Pragma("unroll") for (int j_ = 0; j_ < 4; ++j_) { \
            const int id = tid_ + 512 * j_, n = id & 255, kc = id >> 8, ng = cn0 + n; \
            int drow = ng; \
            if (cmode == 1) drow = (ng < 1024) ? (256 * (ng >> 7) + (ng & 127)) : (256 * ((ng - 1024) >> 7) + 128 + (ng & 127));     \
            if (cmode == 2 || cmode == 3) drow = 256 * (ng >> 7) + (cmode == 3 ? 128 : 0) + (ng & 127);                               \
            const LAS float* lp = Lt + (8 * kc) * 260 + n; \
            if (cmode >= 1) {     \
                u32x2 o8; o8.x = pack4_fp8_raw(lp[0] * 16.f, lp[260] * 16.f, lp[2 * 260] * 16.f, lp[3 * 260] * 16.f); o8.y = pack4_fp8_raw(lp[4 * 260] * 16.f, lp[5 * 260] * 16.f, lp[6 * 260] * 16.f, lp[7 * 260] * 16.f); \
                *(u32x2*)((unsigned char*)cdst + (size_t)drow * cK + ck0 + 8 * kc) = o8; \
            } else { \
                u32x4 o; o.x = cvt_pk_bf16(lp[0], lp[260]); o.y = cvt_pk_bf16(lp[2 * 260], lp[3 * 260]); o.z = cvt_pk_bf16(lp[4 * 260], lp[5 * 260]); o.w = cvt_pk_bf16(lp[6 * 260], lp[7 * 260]); \
                *(u32x4*)(cdst + (size_t)drow * cK + ck0 + 8 * kc) = o; \
            } } } while (0)
    if (cbeg < cend) { CV_DECODE(cbeg, srcA, dstA, KA, NA, k0A, n0A, modeA); CV_LOAD(preA, srcA, NA, k0A, n0A); }
    if (cbeg + 1 < cend) { CV_DECODE(cbeg + 1, srcB, dstB, KB, NB_, k0B, n0B, modeB); CV_LOAD(preB, srcB, NB_, k0B, n0B); }
    for (int it = cbeg; it < cend; it += 2) {
        CV_ITEM(preA, srcA, dstA, KA, NA, k0A, n0A, modeA, 0, it + 2);
        if (it + 1 < cend) CV_ITEM(preB, srcB, dstB, KB, NB_, k0B, n0B, modeB, 1, it + 3);
    }
    __syncthreads();
#undef CV_DECODE
#undef CV_LOAD
#undef CV_ITEM
}

__device__ __forceinline__ void phase_p0(const Params& p, const Ctx& cx) {
    const int lane_ = opaque_v(lane_id()), tid_ = cx.wave * 64 + lane_;
    LAS float* cact = (LAS float*)(cx.lds + 69632);
#pragma unroll 8
    for (int idx = tid_; idx < NB * DM; idx += NWAVES * 64) { const int b = idx >> 10, k = idx & 1023; const float v = p.c[idx]; cact[k * 16 + b] = v * sigmoidf_(v); }
    __syncthreads();
    {
        LAS float* pw = (LAS float*)cx.lds;
        LAS float* Bb = pw + 17 * 64 * 2;
        LAS float* Cm = Bb + 64 * 16 * 2;
        LAS float* Km = Cm + 16 * 64 * 2;
        LAS float* dv = Km + 16 * 16 * 16;
        for (int it = cx.vcu; it < 2 * SG; it += cx.G) {
            const int si = it >> 6, g = it & 63;
            if (tid_ < 64) {
                const int gi = (si * 64 + g) * 64 + tid_;
                const float dt = expf(p.ssm_log_dt[si * 64 + g]);
                const float lr = p.ssm_lam_re[gi], li = p.ssm_lam_im[gi];
                const float mag = expf(lr * dt); float sn, cs; sincosf(li * dt, &sn, &cs);
                const float ab_re = mag * cs, ab_im = mag * sn;
                const float den = lr * lr + li * li, n_re = ab_re - 1.0f;
                const float f_re = (n_re * lr + ab_im * li) / den, f_im = (ab_im * lr - n_re * li) / den;
                float pr = 1.0f, pi = 0.0f;
                for (int j = 0; j <= 16; ++j) { pw[(j * 64 + tid_) * 2] = pr; pw[(j * 64 + tid_) * 2 + 1] = pi; const float nr = pr * ab_re - pi * ab_im, ni = pr * ab_im + pi * ab_re; pr = nr; pi = ni; }
                for (int c = 0; c < 16; ++c) { const float br = p.ssm_b_re[(size_t)gi * 16 + c], bi = p.ssm_b_im[(size_t)gi * 16 + c];
                    Bb[(tid_ * 16 + c) * 2] = f_re * br - f_im * bi; Bb[(tid_ * 16 + c) * 2 + 1] = f_re * bi + f_im * br; }
            }
            for (int e = tid_; e < 1024; e += NWAVES * 64) { Cm[e * 2] = p.ssm_c_re[(size_t)(si * 64 + g) * 1024 + e]; Cm[e * 2 + 1] = p.ssm_c_im[(size_t)(si * 64 + g) * 1024 + e]; }
            if (tid_ < 16) dv[tid_] = p.ssm_d[si * DM + g * 16 + tid_];
            __syncthreads();
            {
                const int j = tid_ >> 5, co = (tid_ >> 1) & 15, ch = tid_ & 1;
                float a[8];
#pragma unroll
                for (int q = 0; q < 8; ++q) a[q] = 0.f;
                for (int pp = 0; pp < 64; ++pp) {
                    const f32x2 cc = *(const LAS f32x2*)(Cm + (co * 64 + pp) * 2), ww = *(const LAS f32x2*)(pw + (j * 64 + pp) * 2);
                    const float zr = cc[0] * ww[0] - cc[1] * ww[1], zi = cc[0] * ww[1] + cc[1] * ww[0];
                    const LAS f32x4* bp = (const LAS f32x4*)(Bb + (pp * 16 + 8 * ch) * 2);
                    const f32x4 b0 = bp[0], b1 = bp[1], b2 = bp[2], b3 = bp[3];
                    a[0] += zr * b0[0] - zi * b0[1]; a[1] += zr * b0[2] - zi * b0[3]; a[2] += zr * b1[0] - zi * b1[1]; a[3] += zr * b1[2] - zi * b1[3];
                    a[4] += zr * b2[0] - zi * b2[1]; a[5] += zr * b2[2] - zi * b2[3]; a[6] += zr * b3[0] - zi * b3[1]; a[7] += zr * b3[2] - zi * b3[3];
                }
#pragma unroll
                for (int q = 0; q < 8; ++q) Km[(j * 16 + co) * 16 + 8 * ch + q] = a[q];
            }
            __syncthreads();
            bf16_t* TH = (bf16_t*)(p.ws + WS_SSMM + (size_t)si * 20 * MiB) + (size_t)g * 256 * 384;
            bf16_t* Gm = (bf16_t*)(p.ws + WS_SSMM + (size_t)si * 20 * MiB + 12 * MiB) + (size_t)g * 256 * 256;
            for (int ch = tid_; ch < 256 * 48; ch += NWAVES * 64) {
                const int n = ch / 48, kk0 = (ch % 48) * 8, t = n >> 4, co = n & 15; float v[8];
#pragma unroll
                for (int q = 0; q < 8; ++q) { const int kk = kk0 + q;
                    if (kk < 256) { const int s_ = kk >> 4, ci = kk & 15; v[q] = (s_ <= t) ? Km[((t - s_) * 16 + co) * 16 + ci] + ((s_ == t && ci == co) ? dv[co] : 0.f) : 0.f; }
                    else { const int pp = (kk - 256) & 63, im = (kk - 256) >> 6;
                        const float cr = Cm[(co * 64 + pp) * 2], cim = Cm[(co * 64 + pp) * 2 + 1], wr_ = pw[((t + 1) * 64 + pp) * 2], wi_ = pw[((t + 1) * 64 + pp) * 2 + 1];
                        v[q] = im ? -(cr * wi_ + cim * wr_) : (cr * wr_ - cim * wi_); } }
                u32x4 o; o.x = cvt_pk_bf16(v[0], v[1]); o.y = cvt_pk_bf16(v[2], v[3]); o.z = cvt_pk_bf16(v[4], v[5]); o.w = cvt_pk_bf16(v[6], v[7]);
                *(u32x4*)(TH + (size_t)n * 384 + kk0) = o;
            }
            for (int ch = tid_; ch < 256 * 32; ch += NWAVES * 64) {
                const int n = ch >> 5, kk0 = (ch & 31) * 8; float v[8];
#pragma unroll
                for (int q = 0; q < 8; ++q) { const int kk = kk0 + q, s_ = kk >> 4, ci = kk & 15;
                    if (n < 128) { const int pp = n & 63, im = n >> 6; const float wr_ = pw[((15 - s_) * 64 + pp) * 2], wi_ = pw[((15 - s_) * 64 + pp) * 2 + 1], br = Bb[(pp * 16 + ci) * 2], bi = Bb[(pp * 16 + ci) * 2 + 1];
                        v[q] = im ? (wr_ * bi + wi_ * br) : (wr_ * br - wi_ * bi); }
                    else v[q] = 0.f; }
                u32x4 o; o.x = cvt_pk_bf16(v[0], v[1]); o.y = cvt_pk_bf16(v[2], v[3]); o.z = cvt_pk_bf16(v[4], v[5]); o.w = cvt_pk_bf16(v[6], v[7]);
                *(u32x4*)(Gm + (size_t)n * 256 + kk0) = o;
            }
            __syncthreads();
        }
    }
    float* ada = (float*)(p.ws + WS_ADA);
    float* abar = (float*)(p.ws + WS_SSMP);
    constexpr int N_ADA_IT = 4 * 384, N_SSM_IT = 2 * 64;
    constexpr int N_ITEMS = N_ADA_IT + N_SSM_IT;
    for (int it = cx.gw; it < N_ITEMS; it += cx.NGW) {
        if (it < N_ADA_IT) {
            const int l = it / 384, nb = it % 384, cq4 = lane_ & 3, ks = lane_ >> 2, col = nb * 16 + 4 * cq4;
            f32x4 acc[16];
#pragma unroll
            for (int b = 0; b < 16; ++b) acc[b] = (f32x4){0.f, 0.f, 0.f, 0.f};
            const float* W = p.w_ada + (size_t)l * DM * ADA + (size_t)(ks * 64) * ADA + col;
            const LAS float* cs_ = cact + ks * 64 * 16;
            for (int k0 = 0; k0 < 64; k0 += 8) {
                f32x4 w[8];
#pragma unroll
                for (int q = 0; q < 8; ++q) w[q] = *(const f32x4*)(W + (size_t)(k0 + q) * ADA);
#pragma unroll
                for (int q = 0; q < 8; ++q) {
                    const LAS f32x4* cp = (const LAS f32x4*)(cs_ + (k0 + q) * 16);
#pragma unroll
                    for (int b4 = 0; b4 < 4; ++b4) { const f32x4 c4 = cp[b4];
#pragma unroll
                        for (int e = 0; e < 4; ++e) acc[4 * b4 + e] += w[q] * c4[e]; }
                }
            }
#pragma unroll
            for (int b = 0; b < 16; ++b)
#pragma unroll
                for (int e = 0; e < 4; ++e) { float v = acc[b][e]; v += xor_swz<4>(v); v += xor_swz<8>(v); v += xor_swz<16>(v); acc[b][e] = half_sum(v); }
            if (lane_ < 4) { const f32x4 bias = *(const f32x4*)(p.b_ada + l * ADA + col);
#pragma unroll
                for (int b = 0; b < 16; ++b) *(f32x4*)(ada + (size_t)(l * 16 + b) * ADA + col) = acc[b] + bias; }
            continue;
        }
        int r = it - N_ADA_IT;
        if (r < N_SSM_IT) {
            const int si = r >> 6, g = r & 63, pp = lane_, gi = (si * 64 + g) * 64 + pp;
            const float dt = expf(p.ssm_log_dt[si * 64 + g]);
            const float lr = p.ssm_lam_re[gi], li = p.ssm_lam_im[gi];
            const float mag = expf(lr * dt); float sn, cs; sincosf(li * dt, &sn, &cs);
            const float ab_re = mag * cs, ab_im = mag * sn;
            const float den = lr * lr + li * li, n_re = ab_re - 1.0f;
            const float f_re = (n_re * lr + ab_im * li) / den, f_im = (ab_im * lr - n_re * li) / den;
            abar[gi * 2 + 0] = ab_re; abar[gi * 2 + 1] = ab_im;
            continue;
        }
    }
    __syncthreads();
    {
        constexpr int NCI = CI_DENSE + (CONV_IN_TAIL ? 1 : DEPTH) * NE * CI_EXP;
        constexpr int CH = 2, NCH = (NCI + CH - 1) / CH;
        unsigned* ctr = (unsigned*)(p.ws + WS_CTL) + CW_CONV + 7 * 64;
        volatile LAS unsigned* slot = (volatile LAS unsigned*)(cx.lds + MISC_OFF) + 100;
        if (tid_ == 0) *slot = __hip_atomic_fetch_add(ctr, 1u, __ATOMIC_RELAXED, __HIP_MEMORY_SCOPE_AGENT);
        __syncthreads();
        unsigned cur = *slot;
        while (cur < (unsigned)NCH) {
            unsigned nxt = 0;
            if (tid_ == 0) nxt = __hip_atomic_fetch_add(ctr, 1u, __ATOMIC_RELAXED, __HIP_MEMORY_SCOPE_AGENT);
            { const int cbeg = (int)cur * CH; int cend = cbeg + CH; if (cend > NCI) cend = NCI; conv_range(p, cx, tid_, cbeg, cend); }
            if (tid_ == 0) *slot = nxt;
            __syncthreads();
            cur = *slot;
        }
    }
}

template <int MODE>
__device__ __forceinline__ void phase_n1(const Params& p, const Ctx& cx, int l, const float* g2l) {
    const int lane_ = opaque_v(lane_id()), tid_ = cx.wave * 64 + lane_;
    const float* ada = (const float*)(p.ws + WS_ADA);
    const unsigned char* Y8 = (const unsigned char*)(p.ws + WS_R + R_Y);
    bf16_t* H = (bf16_t*)((char*)p.out + OUT_H);
    bf16_t* XB = (bf16_t*)(p.ws + WS_XB);
    if (MODE != 2) {
        const float* We = p.moe_w_expert + (size_t)l * DM * NE; const float* Wg = p.moe_w_group + (size_t)l * DM * 4; const float* gn = p.norm_ffn + l * DM;
        unsigned char* WR = p.ws + WS_WR; float* WRC = (float*)(p.ws + WS_WR + 16 * 147456);
        for (int it = cx.gw * 64 + lane_; it < 16 * 36 * 128; it += cx.NGW * 64) {
            const int b = it / 4608, rem = it % 4608, chunk = rem / 36, j = rem % 36, k0 = chunk * 8; float w[8];
            const float* sc2 = ada + (size_t)(l * 16 + b) * ADA + 4096;
#pragma unroll
            for (int q = 0; q < 8; ++q) { const int k = k0 + q; const float wv = (j < 32) ? We[k * NE + j] : Wg[k * 4 + (j - 32)]; w[q] = wv * gn[k] * (1.0f + sc2[k]); }
            u32x4 hi, lo;
            hi.x = cvt_pk_bf16(w[0], w[1]); hi.y = cvt_pk_bf16(w[2], w[3]); hi.z = cvt_pk_bf16(w[4], w[5]); hi.w = cvt_pk_bf16(w[6], w[7]);
            lo.x = cvt_pk_bf16(w[0] - bf_lo(hi.x), w[1] - bf_hi(hi.x)); lo.y = cvt_pk_bf16(w[2] - bf_lo(hi.y), w[3] - bf_hi(hi.y));
            lo.z = cvt_pk_bf16(w[4] - bf_lo(hi.z), w[5] - bf_hi(hi.z)); lo.w = cvt_pk_bf16(w[6] - bf_lo(hi.w), w[7] - bf_hi(hi.w));
            const unsigned off = (unsigned)(j * 2048 + ((chunk & ~15) | ((chunk ^ j) & 15)) * 16);
            *(u32x4*)(WR + (size_t)b * 147456 + off) = hi; *(u32x4*)(WR + (size_t)b * 147456 + 73728 + off) = lo;
        }
        for (int it = cx.gw; it < 16 * 36; it += cx.NGW) {
            const int b = it / 36, j = it % 36; const float* sh2 = ada + (size_t)(l * 16 + b) * ADA + 3072; float a = 0.f;
#pragma unroll
            for (int q = 0; q < 16; ++q) { const int k = lane_ + 64 * q; a += sh2[k] * ((j < 32) ? We[k * NE + j] : Wg[k * 4 + (j - 32)]); }
            a = wave_sum(a);
            if (lane_ == 0) WRC[b * 48 + j] = a + ((j < 32) ? p.moe_b_expert[l * NE + j] : p.moe_b_group[l * 4 + j - 32]);
        }
    }
    for (int rb = cx.gw; rb < NTOK / 16; rb += cx.NGW) {
        const int row0 = rb * 16, b = row0 >> 11;
        f32x4 A[2][2], Bv[2][2], G2[2][2];
#pragma unroll
        for (int j = 0; j < 2; ++j)
#pragma unroll
            for (int q = 0; q < 2; ++q) { const int col = 8 * lane_ + 512 * j + 4 * q;
                if (MODE != 2) { const f32x4 gain = *(const f32x4*)(p.norm_mix + l * DM + col); const f32x4 sc = *(const f32x4*)(ada + (size_t)(l * 16 + b) * ADA + 1024 + col);
                    A[j][q] = gain * (sc + 1.0f); Bv[j][q] = *(const f32x4*)(ada + (size_t)(l * 16 + b) * ADA + col); }
                if (MODE != 0) G2[j][q] = *(const f32x4*)(g2l + (size_t)b * ADA + col); }
        for (int r = 0; r < 16; r += 2) {
            f32x4 v[2][2][2]; float ss[2];
#pragma unroll
            for (int rr = 0; rr < 2; ++rr) {
                const size_t row = (size_t)(row0 + r + rr); ss[rr] = 0.f;
#pragma unroll
                for (int j = 0; j < 2; ++j) { const int col = 8 * lane_ + 512 * j;
                    if (MODE == 0) { v[rr][j][0] = *(const f32x4*)(p.x + row * DM + col); v[rr][j][1] = *(const f32x4*)(p.x + row * DM + col + 4); }
                    else {
                        const u32x4 xb = *(const u32x4*)(XB + row * DM + col);
                        const u32x2 y0 = *(const u32x2*)(Y8 + row * DM + col), y1 = *(const u32x2*)(Y8 + ((size_t)NTOK + row) * DM + col);
                        const f32x4 ys0 = unpack4_fp8(y0.x) + unpack4_fp8(y1.x), ys1 = unpack4_fp8(y0.y) + unpack4_fp8(y1.y);
                        f32x4 x0, x1;
                        x0[0] = bf_lo(xb.x); x0[1] = bf_hi(xb.x); x0[2] = bf_lo(xb.y); x0[3] = bf_hi(xb.y);
                        x1[0] = bf_lo(xb.z); x1[1] = bf_hi(xb.z); x1[2] = bf_lo(xb.w); x1[3] = bf_hi(xb.w);
                        v[rr][j][0] = x0 + G2[j][0] * ys0; v[rr][j][1] = x1 + G2[j][1] * ys1; }
                    const f32x4 a0 = v[rr][j][0], a1 = v[rr][j][1];
                    if (MODE == 2) { *(f32x4*)(p.out + row * DM + col) = a0; *(f32x4*)(p.out + row * DM + col + 4) = a1; }
                    else { u32x4 w; w.x = cvt_pk_bf16(a0[0], a0[1]); w.y = cvt_pk_bf16(a0[2], a0[3]); w.z = cvt_pk_bf16(a1[0], a1[1]); w.w = cvt_pk_bf16(a1[2], a1[3]); *(u32x4*)(XB + row * DM + col) = w; }
                    ss[rr] += ((a0[0] * a0[0] + a0[1] * a0[1]) + (a0[2] * a0[2] + a0[3] * a0[3])) + ((a1[0] * a1[0] + a1[1] * a1[1]) + (a1[2] * a1[2] + a1[3] * a1[3])); }
            }
            if (MODE != 2) {
#pragma unroll
                for (int rr = 0; rr < 2; ++rr) ss[rr] = wave_sum(ss[rr]);
#pragma unroll
                for (int rr = 0; rr < 2; ++rr) {
                    const size_t row = (size_t)(row0 + r + rr);
                    const float rstd = rsqrtf(ss[rr] * (1.0f / DM) + RMS_EPS);
#pragma unroll
                    for (int j = 0; j < 2; ++j) { const int col = 8 * lane_ + 512 * j; const f32x4 h0 = v[rr][j][0] * rstd * A[j][0] + Bv[j][0], h1 = v[rr][j][1] * rstd * A[j][1] + Bv[j][1];
                        if (l & 1) { u32x2 w8; w8.x = pack4_fp8_raw(h0[0], h0[1], h0[2], h0[3]); w8.y = pack4_fp8_raw(h1[0], h1[1], h1[2], h1[3]); *(u32x2*)((unsigned char*)H + row * DM + col) = w8; }
                        else { u32x4 w; w.x = cvt_pk_bf16(h0[0], h0[1]); w.y = cvt_pk_bf16(h0[2], h0[3]); w.z = cvt_pk_bf16(h1[0], h1[1]); w.w = cvt_pk_bf16(h1[2], h1[3]); *(u32x4*)(H + row * DM + col) = w; } }
                }
            }
        }
    }
}

__device__ __forceinline__ float ssq8(const u32x4 w) { const float a0 = bf_lo(w.x), a1 = bf_hi(w.x), a2 = bf_lo(w.y), a3 = bf_hi(w.y), a4 = bf_lo(w.z), a5 = bf_hi(w.z), a6 = bf_lo(w.w), a7 = bf_hi(w.w);
    return (a0 * a0 + a1 * a1) + (a2 * a2 + a3 * a3) + (a4 * a4 + a5 * a5) + (a6 * a6 + a7 * a7); }
typedef float f32x4v __attribute__((ext_vector_type(4)));
__device__ __forceinline__ unsigned n2_wslot(int j, int chunk) { return (unsigned)(j * 2048 + ((chunk & ~15) | ((chunk ^ j) & 15)) * 16); }
__device__ __forceinline__ void phase_n2(const Params& p, const Ctx& cx, int l, int cl) {
    const int lane_ = opaque_v(lane_id()), tid_ = cx.wave * 64 + lane_;
    const float* ada = (const float*)(p.ws + WS_ADA);
    unsigned char* H8 = (unsigned char*)p.out + OUT_H;
    const bf16_t* XB = (const bf16_t*)(p.ws + WS_XB);
    LAS unsigned char* Whi = cx.lds;
    LAS unsigned char* Wlo = cx.lds + 73728;
    LAS float* LG = (LAS float*)cx.lds;
    LAS int* cnt = (LAS int*)(cx.lds + N2_TAB);
    LAS int* basev = cnt + 32;
    LAS int* ri_e = cnt + 64;
    LAS int* ri_s = cnt + 64 + 256;
    LAS float* ri_g = (LAS float*)(cnt + 64 + 512);
    LAS float* rs = (LAS float*)(cnt + 64 + 768);
    LAS float* cb = rs + 128;
    unsigned* gcnt = (unsigned*)(p.ws + WS_CTL) + CW_GCNT + cl * 32 * 64;
    u32x2* list = (u32x2*)(p.ws + WS_LIST);
    const float* We = p.moe_w_expert + (size_t)l * DM * NE; const float* Wg = p.moe_w_group + (size_t)l * DM * 4;
    for (int rb = cx.vcu; rb < NTOK / 128; rb += cx.G) {
        const int wrow0 = rb * 128 + cx.wave * 16, b = wrow0 >> 11;
        const float* sc2 = ada + (size_t)(l * 16 + b) * ADA + 4096; const float* sh2 = ada + (size_t)(l * 16 + b) * ADA + 3072; const float* gn = p.norm_ffn + l * DM;
        if (tid_ < 32) cnt[tid_] = 0;
        const int c16 = lane_ & 15, fq = lane_ >> 4;
        const bf16_t* xr = XB + (size_t)(wrow0 + c16) * DM + 16 * fq;
        u32x4 xq[16][2];
#define N2_LD(S_) do { xq[S_][0] = *(const u32x4*)(xr + 64 * (S_)); xq[S_][1] = *(const u32x4*)(xr + 64 * (S_) + 8); } while (0)
        N2_LD(0); N2_LD(1); N2_LD(2); N2_LD(3);
        {
            const u32x4* src = (const u32x4*)(p.ws + WS_WR + (size_t)b * 147456);
#pragma unroll 6
            for (int i = tid_; i < 147456 / 16; i += NWAVES * 64) ((LAS u32x4*)cx.lds)[i] = src[i];
            if (tid_ < 36) cb[tid_] = ((const float*)(p.ws + WS_WR + 16 * 147456))[b * 48 + tid_];
            LAS float* AB = (LAS float*)(cx.lds + N2_AB);
#pragma unroll
            for (int q = 0; q < 2; ++q) { const int k = tid_ + 512 * q; AB[k] = gn[k] * (1.0f + sc2[k]); AB[1024 + k] = sh2[k]; }
        }
        __syncthreads();
        f32x4v acc[3];
#pragma unroll
        for (int t = 0; t < 3; ++t) acc[t] = (f32x4v){0.f, 0.f, 0.f, 0.f};
        float ssq = 0.f;
        {
            const int j2 = (32 + c16) < 36 ? (32 + c16) : 35;
            int wb[3];
#pragma unroll
            for (int t = 0; t < 3; ++t) { const int j = (t == 2) ? j2 : 16 * t + c16; wb[t] = j * 2048 + 16 * (((2 * fq) ^ j) & 15); }
#pragma unroll
            for (int S = 0; S < 16; ++S) {
                __builtin_amdgcn_sched_barrier(0);
                if (S + 4 < 16) N2_LD(S + 4);
                __builtin_amdgcn_sched_barrier(0);
#pragma unroll
                for (int u = 0; u < 2; ++u) {
                    bf16x8 wh[3], wl[3];
#pragma unroll
                    for (int t = 0; t < 3; ++t) { const int a = opaque_v(wb[t]) ^ (16 * (u | 8 * (S & 1)));
                        wh[t] = *(const LAS bf16x8*)(Whi + a + 256 * (S >> 1)); wl[t] = *(const LAS bf16x8*)(Whi + (a + 73728) + 256 * (S >> 1)); }
                    const u32x4 xw = xq[S][u];
                    const bf16x8 xa = __builtin_bit_cast(bf16x8, xw);
#pragma unroll
                    for (int t = 0; t < 3; ++t) acc[t] = __builtin_amdgcn_mfma_f32_16x16x32_bf16(xa, wh[t], acc[t], 0, 0, 0);
#pragma unroll
                    for (int t = 0; t < 3; ++t) acc[t] = __builtin_amdgcn_mfma_f32_16x16x32_bf16(xa, wl[t], acc[t], 0, 0, 0);
                    ssq += ssq8(xw);
                }
            }
        }
#undef N2_LD
        {
            ssq += xor_swz<16>(ssq); ssq = half_sum(ssq);
            const float rstd = rsqrtf(ssq * (1.0f / DM) + RMS_EPS);
            const int lane3 = opaque_v(lane_id()), c16c = lane3 & 15, fqc = lane3 >> 4;
            if (fqc == 0) rs[cx.wave * 16 + c16c] = rstd;
            const LAS float* AB = (const LAS float*)(cx.lds + opaque_v(N2_AB + 64 * fqc));
            unsigned char* hrow = H8 + (size_t)(wrow0 + c16c) * DM + 16 * fqc;
#pragma unroll
            for (int S = 0; S < 16; ++S) {
                __builtin_amdgcn_sched_barrier(0);
                u32x4 w8;
#pragma unroll
                for (int u = 0; u < 2; ++u) {
                    const int k0 = 64 * S + 8 * u;
                    const f32x4 a0 = *(const LAS f32x4*)(AB + k0), a1 = *(const LAS f32x4*)(AB + k0 + 4), b0 = *(const LAS f32x4*)(AB + 1024 + k0), b1 = *(const LAS f32x4*)(AB + 1024 + k0 + 4);
                    u32x4 pk = xq[S][u]; asm volatile("" : "+v"(pk));
                    const float h0 = bf_lo(pk.x) * (rstd * a0[0]) + b0[0], h1 = bf_hi(pk.x) * (rstd * a0[1]) + b0[1], h2_ = bf_lo(pk.y) * (rstd * a0[2]) + b0[2], h3 = bf_hi(pk.y) * (rstd * a0[3]) + b0[3];
                    const float h4 = bf_lo(pk.z) * (rstd * a1[0]) + b1[0], h5 = bf_hi(pk.z) * (rstd * a1[1]) + b1[1], h6 = bf_lo(pk.w) * (rstd * a1[2]) + b1[2], h7 = bf_hi(pk.w) * (rstd * a1[3]) + b1[3];
                    const unsigned lo_ = pack4_fp8_raw(h0, h1, h2_, h3), hi_ = pack4_fp8_raw(h4, h5, h6, h7);
                    if (u == 0) { w8.x = lo_; w8.y = hi_; } else { w8.z = lo_; w8.w = hi_; }
                }
                *(u32x4*)(hrow + 64 * S) = w8;
            }
        }
        __syncthreads();
        const int lane2 = opaque_v(lane_id()), tid2 = cx.wave * 64 + lane2, c16b = lane2 & 15, fqb = lane2 >> 4;
        {
            LAS float* lgw = LG + cx.wave * (16 * 48);
#pragma unroll
            for (int t = 0; t < 3; ++t)
#pragma unroll
                for (int i = 0; i < 4; ++i) { const int rho = 4 * fqb + i, col = 16 * t + c16b; if (col < 36) lgw[rho * 48 + col] = acc[t][i] * rs[cx.wave * 16 + rho] + cb[col]; }
            asm volatile("s_waitcnt lgkmcnt(0)" ::: "memory");
            if (lane2 < 16) {
                const LAS float* lr = lgw + lane2 * 48;
                int gi = 0; float gm = lr[32];
#pragma unroll
                for (int i = 1; i < 4; ++i) { const float v = lr[32 + i]; if (v > gm) { gm = v; gi = i; } }
                float gden = 0.f;
#pragma unroll
                for (int i = 0; i < 4; ++i) gden += __expf(lr[32 + i] - gm);
                const float gwt = 1.0f / gden;
                float l1 = -3.0e38f, l2 = -3.0e38f; int i1 = 0, i2 = 0;
#pragma unroll
                for (int i = 0; i < 8; ++i) { const float ev = lr[gi * 8 + i];
                    if (ev > l1) { l2 = l1; i2 = i1; l1 = ev; i1 = i; } else if (ev > l2) { l2 = ev; i2 = i; } }
                const float tt = __expf(l2 - l1), p1 = 1.0f / (1.0f + tt), p2 = tt * p1;
                const int rloc = cx.wave * 16 + lane2, e1 = gi * 8 + i1, e2 = gi * 8 + i2;
                const int s1 = __hip_atomic_fetch_add(cnt + e1, 1, __ATOMIC_RELAXED, __HIP_MEMORY_SCOPE_WORKGROUP);
                const int s2 = __hip_atomic_fetch_add(cnt + e2, 1, __ATOMIC_RELAXED, __HIP_MEMORY_SCOPE_WORKGROUP);
                ri_e[rloc * 2] = e1; ri_e[rloc * 2 + 1] = e2; ri_s[rloc * 2] = s1; ri_s[rloc * 2 + 1] = s2; ri_g[rloc * 2] = gwt * p1; ri_g[rloc * 2 + 1] = gwt * p2;
            }
        }
        __syncthreads();
        if (tid2 < 32) basev[tid2] = (int)__hip_atomic_fetch_add(gcnt + tid2 * 64, (unsigned)cnt[tid2], __ATOMIC_RELAXED, __HIP_MEMORY_SCOPE_AGENT);
        __syncthreads();
        if (tid2 < 256) { const int e = ri_e[tid2], slot = basev[e] + ri_s[tid2]; const unsigned tok = (unsigned)(rb * 128 + (tid2 >> 1));
            u32x2 ent; ent.x = tok * 2u + (unsigned)(tid2 & 1); ent.y = __float_as_uint(ri_g[tid2]); list[(size_t)e * NTOK + slot] = ent; }
        __syncthreads();
    }
}

template <int NCT, bool WITH_GATE>
__device__ __forceinline__ int moe_setup(const Params& p, const Ctx& cx, int l) {
    const int lane_ = opaque_v(lane_id()), tid_ = cx.wave * 64 + lane_;
    LAS int* utab = (LAS int*)(cx.lds + MOE_TAB);
    LAS int* nun = utab + MAXU * 8;
    LAS int* ecnt = (LAS int*)(cx.lds + 65536);
    unsigned* gcnt = (unsigned*)(p.ws + WS_CTL) + CW_GCNT + l * 32 * 64;
    const u32x2* list = (const u32x2*)(p.ws + WS_LIST);
    LAS int* toff = ecnt + 32;
    if (tid_ < 32) ecnt[tid_] = (int)__hip_atomic_load(gcnt + tid_ * 64, __ATOMIC_RELAXED, __HIP_MEMORY_SCOPE_AGENT);
    __syncthreads();
    if (tid_ < 32) {
        int acc = 0;
        for (int e = 0; e < 32; ++e) { const int ntl = (ecnt[e] + 255) >> 8; acc += (e < tid_) ? ntl : 0; }
        toff[tid_] = acc;
        if (tid_ == 31) toff[32] = acc + ((ecnt[31] + 255) >> 8);
    }
    __syncthreads();
    if (tid_ < MAXU) {
        const int T = toff[32], i = tid_;
        const int L = i * cx.G + cx.vcu, t = L / NCT, pn = L % NCT;
        int valid = (t < T) ? 1 : 0, e = 0;
        for (int q = 0; q < 32; ++q) e = (toff[q] <= t) ? q : e;
        const int tie = t - toff[e]; int rows = ecnt[e] - tie * 256; rows = rows > 256 ? 256 : rows;
        if (valid) { utab[i * 8 + 0] = t; utab[i * 8 + 1] = pn; utab[i * 8 + 2] = e; utab[i * 8 + 3] = rows; utab[i * 8 + 4] = tie; }
        const unsigned long long m = __ballot(valid != 0);
        if (tid_ == 0) { *nun = __popcll(m); nun[1] = T; }
    }
    __syncthreads();
    const int nu = *nun;
    for (int i = 0; i < nu; ++i) {
        const int e = utab[i * 8 + 2], rows = utab[i * 8 + 3], tie = utab[i * 8 + 4];
        if (tid_ < 256) {
            const bool valid = tid_ < rows;
            u32x2 ent; ent.x = 0xffffffffu; ent.y = 0u;
            if (valid) ent = list[(size_t)e * NTOK + tie * 256 + tid_];
            if (WITH_GATE) ((LAS u32x2*)(cx.lds + MOE_TAB + 256))[i * 256 + tid_] = ent;
            else ((LAS unsigned*)(cx.lds + MOE_TAB + 256))[i * 256 + tid_] = valid ? (ent.x >> 1) : 0u;
        }
    }
    if (WITH_GATE) {
        LAS unsigned* idt = (LAS unsigned*)(cx.lds + MOE_TAB + 256 + MAXU * 256 * 8);
        for (int i = 0; i < nu; ++i) if (tid_ < 256) idt[i * 256 + tid_] = (unsigned)(utab[i * 8 + 0] * 256 + tid_);
    }
    __syncthreads();
    return nu;
}

typedef float f32x16 __attribute__((ext_vector_type(16)));
__device__ __forceinline__ float half_max(float v) { const auto r = __builtin_amdgcn_permlane32_swap(__float_as_uint(v), __float_as_uint(v), false, false); return fmaxf(__uint_as_float(r[0]), __uint_as_float(r[1])); }
__device__ __forceinline__ void phase_attn(const Params& p, const Ctx& cx, int li, bf16_t* Odst) {
    const int lane_ = opaque_v(lane_id()), tid_ = cx.wave * 64 + lane_, r = lane_ & 31, h = lane_ >> 5;
    bf16_t* Q = (bf16_t*)(p.ws + WS_R + R_Q);
    const bf16_t* Kb = (const bf16_t*)(p.ws + WS_R + R_K);
    const bf16_t* Vt = (const bf16_t*)(p.ws + WS_R + R_VT);
    constexpr float LOG2E = 1.4426950408889634f;
    constexpr int ABUF = 49152, AKS = 0, AVS = 24576, AGL = 2 * ABUF;
    LAS float* gl = (LAS float*)(cx.lds + AGL);
    if (lane_ < HD) gl[lane_] = p.attn_q_gain[li * HD + lane_] * p.attn_k_gain[li * HD + lane_];
    const int qtl = cx.wave >> 2, hl = cx.wave & 3;
    const int NU = NB * NKVH * (SEQ / 64);
    u32x4 kpre[3], vpre[3], qpre[4];
#define ATT_PREFETCH(u_) do { const int b_ = (u_) >> 7, kvh_ = ((u_) >> 5) & 3, kb_ = ((u_) & 31) * 64 - 128; \
        { const bf16_t* qp_ = Q + ((size_t)(b_ * SEQ + kb_ + 128 + 32 * qtl + r)) * 1024 + (kvh_ * 4 + hl) * 64 + 8 * h; _Pragma("unroll") for (int s_ = 0; s_ < 4; ++s_) qpre[s_] = *(const u32x4*)(qp_ + 16 * s_); } \
        _Pragma("unroll") for (int j_ = 0; j_ < 3; ++j_) { const int idx = tid_ + 512 * j_; \
            { const int row = idx >> 3, c = idx & 7; int key = kb_ + row; key = key < 0 ? 0 : key; kpre[j_] = *(const u32x4*)(Kb + ((size_t)(b_ * SEQ + key)) * 256 + kvh_ * 64 + 8 * c); } \
            { const int d = idx / 24, ch = idx % 24; int key0 = kb_ + 32 * (ch >> 2); key0 = key0 < 0 ? 0 : key0; vpre[j_] = *(const u32x4*)(Vt + ((size_t)((b_ * 4 + kvh_) * 64 + d)) * 2048 + key0 + 8 * (ch & 3)); } } } while (0)
#define ATT_COMMIT(buf_) do { LAS unsigned char* kb2 = cx.lds + (buf_) * ABUF + AKS; LAS unsigned char* vb2 = cx.lds + (buf_) * ABUF + AVS; \
        _Pragma("unroll") for (int j_ = 0; j_ < 3; ++j_) { const int idx = tid_ + 512 * j_; \
            { const int row = idx >> 3, c = idx & 7; float ss = ssq8(kpre[j_]); ss += xor_swz<1>(ss); ss += xor_swz<2>(ss); ss += xor_swz<4>(ss); const float rk = rsqrtf(ss * (1.0f / HD) + RMS_EPS); u32x4 o; \
              o.x = cvt_pk_bf16(bf_lo(kpre[j_].x) * rk, bf_hi(kpre[j_].x) * rk); o.y = cvt_pk_bf16(bf_lo(kpre[j_].y) * rk, bf_hi(kpre[j_].y) * rk); o.z = cvt_pk_bf16(bf_lo(kpre[j_].z) * rk, bf_hi(kpre[j_].z) * rk); o.w = cvt_pk_bf16(bf_lo(kpre[j_].w) * rk, bf_hi(kpre[j_].w) * rk); \
              *(LAS u32x4*)(kb2 + row * 128 + ((c ^ ((row >> 1) & 7)) << 4)) = o; } \
            { const int d = idx / 24, ch = idx % 24; *(LAS u32x4*)(vb2 + d * 384 + ((ch ^ ((d >> 1) & 7)) << 4)) = vpre[j_]; } } } while (0)
    int u = cx.vcu, buf = 0;
    if (u < NU) { ATT_PREFETCH(u); ATT_COMMIT(0); }
    __syncthreads();
    for (; u < NU; u += cx.G) {
        const int b = u >> 7, kvh = (u >> 5) & 3, q0 = (u & 31) * 64 + 32 * qtl, hq = kvh * 4 + hl, kpos0 = q0 - 128;
        const int kt0 = q0 >= 128 ? 0 : 4 - (q0 >> 5);
        const bool has_next = (u + cx.G) < NU;
        u32x4 qw[4];
#pragma unroll
        for (int s_ = 0; s_ < 4; ++s_) qw[s_] = qpre[s_];
        if (has_next) ATT_PREFETCH(u + cx.G);
        const LAS unsigned char* ks = cx.lds + buf * ABUF + AKS; const LAS unsigned char* vs = cx.lds + buf * ABUF + AVS;
        bf16x8 bq[4];
        {
            float ssq = 0.f;
#pragma unroll
            for (int s_ = 0; s_ < 4; ++s_) ssq += ssq8(qw[s_]);
            ssq = half_sum(ssq);
            const float rq = rsqrtf(ssq * (1.0f / HD) + RMS_EPS) * (0.125f * LOG2E);
            f32x4 gqk[4][2];
#pragma unroll
            for (int s_ = 0; s_ < 4; ++s_) { gqk[s_][0] = *(const LAS f32x4*)(gl + 16 * s_ + 8 * h); gqk[s_][1] = *(const LAS f32x4*)(gl + 16 * s_ + 8 * h + 4); }
#pragma unroll
            for (int s_ = 0; s_ < 4; ++s_) { u32x4 o;
                o.x = cvt_pk_bf16(bf_lo(qw[s_].x) * rq * gqk[s_][0][0], bf_hi(qw[s_].x) * rq * gqk[s_][0][1]); o.y = cvt_pk_bf16(bf_lo(qw[s_].y) * rq * gqk[s_][0][2], bf_hi(qw[s_].y) * rq * gqk[s_][0][3]);
                o.z = cvt_pk_bf16(bf_lo(qw[s_].z) * rq * gqk[s_][1][0], bf_hi(qw[s_].z) * rq * gqk[s_][1][1]); o.w = cvt_pk_bf16(bf_lo(qw[s_].w) * rq * gqk[s_][1][2], bf_hi(qw[s_].w) * rq * gqk[s_][1][3]);
                bq[s_] = __builtin_bit_cast(bf16x8, o); }
        }
        f32x16 st[5];
#pragma unroll
        for (int kt = 0; kt < 5; ++kt) {
            const int row = 32 * (qtl + kt) + r;
            f32x16 acc;
#pragma unroll
            for (int e = 0; e < 16; ++e) acc[e] = 0.f;
#pragma unroll
            for (int s_ = 0; s_ < 4; ++s_) { const bf16x8 kf = *(const LAS bf16x8*)(ks + row * 128 + (((2 * s_ + h) ^ ((row >> 1) & 7)) << 4));
                acc = __builtin_amdgcn_mfma_f32_32x32x16_bf16(kf, bq[s_], acc, 0, 0, 0); }
#pragma unroll
            for (int e = 0; e < 16; ++e) {
                const int row0 = (e & 3) + 8 * (e >> 2);
                float v = acc[e];
                if (kt == 0) v = (row0 + 4 * h >= r + 1) ? v : -INFINITY;
                if (kt == 4) v = (row0 + 4 * h <= r) ? v : -INFINITY;
                if (kt < 4) v = (kt >= kt0) ? v : -INFINITY;
                acc[e] = v;
            }
            st[kt] = acc;
        }
        const float sink2 = p.attn_sinks[li * NQH + hq] * LOG2E;
        float m = sink2;
#pragma unroll
        for (int kt = 0; kt < 5; ++kt)
#pragma unroll
            for (int e = 0; e < 16; ++e) m = fmaxf(m, st[kt][e]);
        m = half_max(m);
        float lsum = 0.f;
        f32x16 o0, o1;
#pragma unroll
        for (int e = 0; e < 16; ++e) { o0[e] = 0.f; o1[e] = 0.f; }
#pragma unroll
        for (int kt = 0; kt < 5; ++kt) {
#pragma unroll
            for (int e = 0; e < 16; ++e) { const float pv = __builtin_amdgcn_exp2f(st[kt][e] - m); st[kt][e] = pv; lsum += pv; }
#pragma unroll
            for (int s_ = 0; s_ < 2; ++s_) {
                u32x4 pw;
                pw.x = cvt_pk_bf16(st[kt][8 * s_ + 0], st[kt][8 * s_ + 1]); pw.y = cvt_pk_bf16(st[kt][8 * s_ + 2], st[kt][8 * s_ + 3]);
                pw.z = cvt_pk_bf16(st[kt][8 * s_ + 4], st[kt][8 * s_ + 5]); pw.w = cvt_pk_bf16(st[kt][8 * s_ + 6], st[kt][8 * s_ + 7]);
                const int ch = 4 * (qtl + kt) + 2 * h + s_;
                const bf16x8 av0 = *(const LAS bf16x8*)(vs + r * 384 + ((ch ^ ((r >> 1) & 7)) << 4));
                const bf16x8 av1 = *(const LAS bf16x8*)(vs + (32 + r) * 384 + ((ch ^ (((32 + r) >> 1) & 7)) << 4));
                o0 = __builtin_amdgcn_mfma_f32_32x32x16_bf16(av0, __builtin_bit_cast(bf16x8, pw), o0, 0, 0, 0);
                o1 = __builtin_amdgcn_mfma_f32_32x32x16_bf16(av1, __builtin_bit_cast(bf16x8, pw), o1, 0, 0, 0);
            }
        }
        lsum = half_sum(lsum) + __builtin_amdgcn_exp2f(sink2 - m);
        const float inv = 1.0f / lsum;
        bf16_t* op = Odst + ((size_t)(b * SEQ + q0 + r)) * 1024 + hq * 64 + 4 * h;
#pragma unroll
        for (int g4 = 0; g4 < 4; ++g4) {
            u32x2 w0; w0.x = cvt_pk_bf16(o0[4 * g4 + 0] * inv, o0[4 * g4 + 1] * inv); w0.y = cvt_pk_bf16(o0[4 * g4 + 2] * inv, o0[4 * g4 + 3] * inv);
            u32x2 w1; w1.x = cvt_pk_bf16(o1[4 * g4 + 0] * inv, o1[4 * g4 + 1] * inv); w1.y = cvt_pk_bf16(o1[4 * g4 + 2] * inv, o1[4 * g4 + 3] * inv);
            *(u32x2*)(op + 8 * g4) = w0; *(u32x2*)(op + 32 + 8 * g4) = w1;
        }
        if (has_next) ATT_COMMIT(buf ^ 1);
        __syncthreads();
        buf ^= 1;
    }
#undef ATT_PREFETCH
#undef ATT_COMMIT
}

__device__ __forceinline__ void phase_ssm_scan(const Params& p, const Ctx& cx, int si) {
    const int lane_ = opaque_v(lane_id()), tid_ = cx.wave * 64 + lane_;
    const float* abar = (const float*)(p.ws + WS_SSMP);
    const bf16_t* Wst = (const bf16_t*)(p.ws + WS_R + R_W);
    bf16_t* US = (bf16_t*)(p.ws + WS_R + R_US);
    for (int it = cx.gw; it < SG * NB; it += cx.NGW) {
        const int g = it >> 4, b = it & 15, gi = (si * 64 + g) * 64 + lane_;
        float ar = abar[gi * 2], ai = abar[gi * 2 + 1];
#pragma unroll
        for (int q = 0; q < 4; ++q) { const float nr = ar * ar - ai * ai, ni = 2.0f * ar * ai; ar = nr; ai = ni; }
        const size_t row0 = (size_t)g * 2048 + b * 128;
        float sr = 0.f, si_ = 0.f;
#pragma unroll 8
        for (int k = 0; k < 128; ++k) {
            const float wr_ = __uint_as_float((unsigned)Wst[(row0 + k) * 128 + lane_] << 16), wi_ = __uint_as_float((unsigned)Wst[(row0 + k) * 128 + 64 + lane_] << 16);
            bf16_t* up = US + (row0 + k) * 384 + 256 + lane_;
            up[0] = (bf16_t)(cvt_pk_bf16(sr, 0.f) & 0xffffu); up[64] = (bf16_t)(cvt_pk_bf16(si_, 0.f) & 0xffffu);
            const float nr = ar * sr - ai * si_ + wr_, ni = ar * si_ + ai * sr + wi_; sr = nr; si_ = ni;
        }
    }
}

__device__ __forceinline__ void moe_tail_convert(const Params& p, const Ctx& cx, int next_layer, int total_units, int lo, int hi) {
    const int rounds = (total_units + cx.G - 1) / cx.G; int n_late = total_units - (rounds - 1) * cx.G; if (n_late >= cx.G) n_late = 0;
    if (cx.vcu < n_late) return;
    const int rank = cx.vcu - n_late, cnt = cx.G - n_late, nit = hi - lo, q = (nit + cnt - 1) / cnt; int cb = rank * q, ce = cb + q; if (cb > nit) cb = nit; if (ce > nit) ce = nit;
    const int lane2 = opaque_v(lane_id()), ibase = CI_DENSE + next_layer * NE * CI_EXP + lo;
    conv_range(p, cx, cx.wave * 64 + lane2, ibase + cb, ibase + ce);
}

__global__ void __launch_bounds__(NWAVES * 64, 2) fwd(Params p_unused) {
    extern __shared__ __attribute__((aligned(16))) unsigned char lds_raw[];
    Ctx cx;
    cx.lds = (LAS unsigned char*)lds_raw;
    const int tid0 = threadIdx.x; cx.wave = __builtin_amdgcn_readfirstlane(tid0 >> 6);
    cx.G = gridDim.x; { const int bx = blockIdx.x; cx.vcu = (cx.G % 8 == 0) ? (bx % 8) * (cx.G / 8) + bx / 8 : bx; }
    cx.gw = cx.vcu * NWAVES + cx.wave; cx.NGW = cx.G * NWAVES;
    unsigned* ctl; { const Params p = load_params(); ctl = (unsigned*)(p.ws + WS_CTL); }
    volatile LAS unsigned* MISC = (volatile LAS unsigned*)(cx.lds + MISC_OFF);
    for (int u = tid0; u < (LDS_BYTES - MISC_OFF) / 4; u += NWAVES * 64) ((LAS unsigned*)(cx.lds + MISC_OFF))[u] = 0u;
    __syncthreads();
    XcdBarrier bar = xcd_barrier_post((gu32*)ctl + CW_BAR, MISC + 8);
#define GRID_BAR() xcd_barrier<false>(bar, cx.wave)

    { const Params p = load_params(); phase_p0(p, cx); __syncthreads(); }
    xcd_barrier<true>(bar, cx.wave);

    for (int l = 0; l < DEPTH; ++l) {
        {
            const Params p = load_params();
            const float* g2l = (const float*)(p.ws + WS_ADA) + (size_t)(l - 1) * 16 * ADA + 5120;
            if (l == 0) phase_n1<0>(p, cx, 0, g2l); else phase_n1<1>(p, cx, l, g2l);
        }
        GRID_BAR();
        const int li = l >> 1;
        if ((l & 1) == 0) {
            {
                const Params p = load_params(); const bf16_t* H = (const bf16_t*)((const char*)p.out + OUT_H);
                pg8::DenseOrder S; S.init(NTOK, QKVD, DM, DM, cx.G, (int)blockIdx.x, H, (const bf16_t*)(p.ws + WS_WATT + (size_t)li * 5 * MiB));
                EpiQKV E{(bf16_t*)(p.ws + WS_R + R_Q), (bf16_t*)(p.ws + WS_R + R_K), (bf16_t*)(p.ws + WS_R + R_VT)};
                pg8::gemm_phase<EpiQKV, pg8::DenseOrder, false, true>(cx.lds, cx.wave, DM, DM, S, E, nullptr);
            }
            GRID_BAR();
            { const Params p = load_params(); phase_attn(p, cx, li, (bf16_t*)(p.ws + WS_R + R_Q)); }
            GRID_BAR();
            {
                const Params p = load_params();
                const float* gl = (const float*)(p.ws + WS_ADA) + (size_t)l * 16 * ADA + 2048;
                pg8::DenseOrder S; S.init(NTOK, DM, DM, DM, cx.G, (int)blockIdx.x, (const bf16_t*)(p.ws + WS_R + R_Q), (const bf16_t*)(p.ws + WS_WATT + (size_t)li * 5 * MiB + 3 * MiB));
                EpiDelta E{(bf16_t*)(p.ws + WS_XB), gl};
                pg8::gemm_phase<EpiDelta, pg8::DenseOrder, false, true>(cx.lds, cx.wave, DM, DM, S, E, nullptr);
            }
            GRID_BAR();
        } else {
            {
                const Params p = load_params(); const bf16_t* H = (const bf16_t*)((const char*)p.out + OUT_H);
                pg8::DenseOrder S; S.init(NTOK, DM, DM / 2, DM / 2, cx.G, (int)blockIdx.x, H, (const bf16_t*)(p.ws + WS_WSSM + (size_t)li * 6 * MiB));
                S.via_table = true;
                {
                    const int lane2 = opaque_v(lane_id()), tid2 = cx.wave * 64 + lane2; LAS unsigned* tab = (LAS unsigned*)(cx.lds + MOE_TAB + 256);
                    pg8::Unit uu; for (int i = 0; i < MAXU && S.next(i, uu); ++i) if (tid2 < 256) tab[i * 256 + tid2] = (unsigned)(uu.pm * 256 + tid2);
                    __syncthreads();
                }
                EpiU E{(bf16_t*)(p.ws + WS_R + R_US)};
                pg8::gemm_phase<EpiU, pg8::DenseOrder, true, true, true>(cx.lds, cx.wave, DM / 2, DM / 2, S, E, (volatile LAS const unsigned*)(cx.lds + MOE_TAB + 256));
            }
            GRID_BAR();
            {
                const Params p = load_params();
                SsmOrder S{cx.G, cx.vcu, 256, (const bf16_t*)(p.ws + WS_R + R_US), (const bf16_t*)(p.ws + WS_SSMM + (size_t)li * 20 * MiB + 12 * MiB), (size_t)256 * 256};
                EpiW E{(bf16_t*)(p.ws + WS_R + R_W)};
                pg8::gemm_phase<EpiW, SsmOrder, false, true>(cx.lds, cx.wave, 256, 384, S, E, nullptr);
            }
            GRID_BAR();
            { const Params p = load_params(); phase_ssm_scan(p, cx, li); }
            GRID_BAR();
            {
                const Params p = load_params();
                SsmOrder S{cx.G, cx.vcu, 384, (const bf16_t*)(p.ws + WS_R + R_US), (const bf16_t*)(p.ws + WS_SSMM + (size_t)li * 20 * MiB), (size_t)256 * 384};
                EpiY E{(bf16_t*)(p.ws + WS_R + R_YG)};
                pg8::gemm_phase<EpiY, SsmOrder, false, true>(cx.lds, cx.wave, 384, 384, S, E, nullptr);
            }
            GRID_BAR();
            {
                const Params p = load_params();
                const float* gl = (const float*)(p.ws + WS_ADA) + (size_t)l * 16 * ADA + 2048;
                pg8::DenseOrder S; S.init(NTOK, 2 * DM, DM / 2, DM / 2, cx.G, (int)blockIdx.x, (const bf16_t*)(p.ws + WS_R + R_YG), (const bf16_t*)(p.ws + WS_WSSM + (size_t)li * 6 * MiB + 2 * MiB));
                EpiGLU E{(bf16_t*)(p.ws + WS_XB), gl};
                S.via_table = true;
                {
                    const int lane2 = opaque_v(lane_id()), tid2 = cx.wave * 64 + lane2; LAS unsigned* tab = (LAS unsigned*)(cx.lds + MOE_TAB + 256);
                    pg8::Unit uu; for (int i = 0; i < MAXU && S.next(i, uu); ++i) if (tid2 < 256) tab[i * 256 + tid2] = (unsigned)(uu.pm * 256 + tid2);
                    __syncthreads();
                }
                pg8::gemm_phase<EpiGLU, pg8::DenseOrder, true, true, true>(cx.lds, cx.wave, DM / 2, DM / 2, S, E, (volatile LAS const unsigned*)(cx.lds + MOE_TAB + 256));
            }
            GRID_BAR();
        }
        { const Params p = load_params(); phase_n2(p, cx, l, l); }
        GRID_BAR();
        {
            const Params p = load_params(); const bf16_t* H = (const bf16_t*)((const char*)p.out + OUT_H);
            const int nu = moe_setup<2, false>(p, cx, l);
            MoeOrder S{(LAS const int*)(cx.lds + MOE_TAB), nu, DM / 2, 0, H, (const bf16_t*)(p.ws + WS_WMOE + (size_t)l * NE * 3 * MiB / 2), 0};
            EpiSwiGLU E{(bf16_t*)((char*)p.out + OUT_HID)};
            pg8::gemm_phase<EpiSwiGLU, MoeOrder, true, true, true>(cx.lds, cx.wave, DM / 2, DM / 2, S, E, (volatile LAS const unsigned*)(cx.lds + MOE_TAB + 256));
            if (CONV_IN_TAIL && l + 1 < DEPTH) { const int TU = 2 * ((LAS const int*)(cx.lds + MOE_TAB))[MAXU * 8 + 1]; __syncthreads(); moe_tail_convert(p, cx, l + 1, TU, 0, 768); }
        }
        GRID_BAR();
        {
            const Params p = load_params();
            const int nu = moe_setup<4, true>(p, cx, l);
            MoeOrder S{(LAS const int*)(cx.lds + MOE_TAB), nu, FE / 2, 0, (const bf16_t*)((const char*)p.out + OUT_HID), (const bf16_t*)(p.ws + WS_WMOE + (size_t)l * NE * 3 * MiB / 2), (size_t)(MiB / 2)};
            EpiDown E{(bf16_t*)(p.ws + WS_R + R_Y)};
            pg8::gemm_phase<EpiDown, MoeOrder, true, true, true>(cx.lds, cx.wave, FE / 2, FE / 2, S, E, (volatile LAS const unsigned*)(cx.lds + MOE_TAB + 256 + MAXU * 256 * 8));
            if (CONV_IN_TAIL && l + 1 < DEPTH) { const int TU = 4 * ((LAS const int*)(cx.lds + MOE_TAB))[MAXU * 8 + 1]; __syncthreads(); moe_tail_convert(p, cx, l + 1, TU, 768, NE * CI_EXP); }
        }
        GRID_BAR();
    }
    { const Params p = load_params(); phase_n1<2>(p, cx, DEPTH, (const float*)(p.ws + WS_ADA) + (size_t)(DEPTH - 1) * 16 * ADA + 5120); }
}

extern "C" void kernel_launch(void* const* d_in, const int* in_sizes, int n_in, void* d_out, int out_size, void* d_ws, size_t ws_size, hipStream_t stream) {
    static int grid = 0;
    if (grid == 0) {
        if (n_in != 28 || out_size != NTOK * DM || ws_size < WS_END) { fprintf(stderr, "kernel_launch: unexpected problem (n_in %d, out %d, ws %zu < %zu); nothing launched\n", n_in, out_size, ws_size, (size_t)WS_END); grid = -1; return; }
        int dev = 0, cus = 0, per_cu = 0;
        if (hipGetDevice(&dev) != hipSuccess || hipDeviceGetAttribute(&cus, hipDeviceAttributeMultiprocessorCount, dev) != hipSuccess) { grid = -1; return; }
        if (hipFuncSetAttribute((const void*)fwd, hipFuncAttributeMaxDynamicSharedMemorySize, LDS_BYTES) != hipSuccess) { fprintf(stderr, "kernel_launch: hipFuncSetAttribute failed\n"); grid = -1; return; }
        if (hipOccupancyMaxActiveBlocksPerMultiprocessor(&per_cu, (const void*)fwd, NWAVES * 64, LDS_BYTES) != hipSuccess || per_cu < 1)
            fprintf(stderr, "kernel_launch: note: occupancy query reports %d workgroups per CU\n", per_cu);
        (void)hipGetLastError();
        grid = cus;
    }
    if (grid < 0) return;
    if (hipMemsetAsync((char*)d_ws + WS_CTL, 0, CTL_ZERO_BYTES, stream) != hipSuccess) return;
    Params p{};
    const float** pf = (const float**)&p;
    for (int i = 0; i < 28; ++i) pf[i] = (const float*)d_in[i];
    p.out = (float*)d_out; p.ws = (unsigned char*)d_ws;
    hipLaunchKernelGGL(fwd, dim3(grid), dim3(NWAVES * 64), LDS_BYTES, stream, p);
}
```

```cpp
#include <hip/hip_runtime.h>
#include <cstdio>
#include <cstdint>

#define LAS __attribute__((address_space(3)))
#define GAS __attribute__((address_space(1)))
typedef unsigned short bf16_t;
typedef short bf16x8 __attribute__((ext_vector_type(8)));
typedef float f32x4 __attribute__((ext_vector_type(4)));
typedef float f32x2 __attribute__((ext_vector_type(2)));
typedef unsigned u32x4 __attribute__((ext_vector_type(4)));
typedef unsigned u32x2 __attribute__((ext_vector_type(2)));

constexpr int NB = 16, SEQ = 2048, DM = 1024, NTOK = NB * SEQ, DEPTH = 4;
constexpr int HD = 64, NQH = 16, NKVH = 4, QKVD = 1536;
constexpr int SG = 64, SP = 64, SC = 16;
constexpr int NE = 32, FE = 256;
constexpr int ADA = 6 * DM;
constexpr float RMS_EPS = 1e-6f;

constexpr size_t MiB = 1u << 20;
constexpr size_t WS_CTL = 0, CTL_ZERO_BYTES = 1 * MiB;
constexpr size_t WS_ADA = 1 * MiB;
constexpr size_t WS_SSMP = 3 * MiB;
constexpr size_t WS_LIST = 5 * MiB;
constexpr size_t WS_WATT = 13 * MiB;
constexpr size_t WS_WSSM = 23 * MiB;
constexpr size_t WS_SSMM = 35 * MiB;
constexpr size_t WS_WMOE = 75 * MiB;
constexpr size_t WS_R = 267 * MiB;
constexpr size_t WS_D = 459 * MiB;
constexpr size_t WS_XB = 523 * MiB;
constexpr size_t WS_WR = 587 * MiB;
constexpr size_t WS_END = 590 * MiB;
constexpr size_t OUT_H = 0, OUT_HID = 64 * MiB;
constexpr size_t R_Q = 0, R_K = 64 * MiB, R_VT = 80 * MiB, R_O8 = 96 * MiB;
constexpr size_t R_US = 0, R_W = 96 * MiB, R_YG = 128 * MiB;
constexpr size_t R_Y = 0;

constexpr int CW_TMO = 0, CW_CODE = 1;
constexpr int CW_BAR = 4096;
constexpr int CW_CONV = 8192;
constexpr int CW_GCNT = 16384;

constexpr int LDS_SCR = 147456;
constexpr int RING_BYTES = 131072;
constexpr int MOE_TAB = 131072;
constexpr int N2_TAB = LDS_SCR;
constexpr int MISC_OFF = LDS_SCR + 4096;
constexpr int N2_AB = MISC_OFF + 512;
constexpr int LDS_BYTES = N2_AB + 8192;
constexpr int MAXU = 6;

constexpr int NWAVES = 8;
constexpr bool CONV_IN_TAIL = true;


__device__ __forceinline__ unsigned cvt_pk_bf16(float lo, float hi) { unsigned r; asm volatile("v_cvt_pk_bf16_f32 %0, %1, %2" : "=v"(r) : "v"(lo), "v"(hi)); return r; }
typedef float f32x2p __attribute__((ext_vector_type(2)));
__device__ __forceinline__ unsigned pack4_fp8(float a, float b, float c, float d) { int w = 0; w = __builtin_amdgcn_cvt_pk_fp8_f32(a * 16.0f, b * 16.0f, w, false); w = __builtin_amdgcn_cvt_pk_fp8_f32(c * 16.0f, d * 16.0f, w, true); return (unsigned)w; }
__device__ __forceinline__ f32x4 unpack4_fp8(unsigned w) { const f32x2p lo = __builtin_amdgcn_cvt_pk_f32_fp8((int)w, false), hi = __builtin_amdgcn_cvt_pk_f32_fp8((int)w, true); f32x4 r; r[0] = lo[0]; r[1] = lo[1]; r[2] = hi[0]; r[3] = hi[1]; return r * 0.0625f; }
__device__ __forceinline__ unsigned pack4_fp8_raw(float a, float b, float c, float d) { int w = 0; w = __builtin_amdgcn_cvt_pk_fp8_f32(a, b, w, false); w = __builtin_amdgcn_cvt_pk_fp8_f32(c, d, w, true); return (unsigned)w; }
__device__ __forceinline__ float bf_lo(unsigned w) { return __uint_as_float(w << 16); }
__device__ __forceinline__ float bf_hi(unsigned w) { return __uint_as_float(w & 0xffff0000u); }
template <int M> __device__ __forceinline__ float xor_swz(float v) { return __int_as_float(__builtin_amdgcn_ds_swizzle(__float_as_int(v), (M << 10) | 0x1f)); }
__device__ __forceinline__ float half_sum(float v) {
    const auto r = __builtin_amdgcn_permlane32_swap(__float_as_uint(v), __float_as_uint(v), false, false);
    return __uint_as_float(r[0]) + __uint_as_float(r[1]);
}
__device__ __forceinline__ float wave_sum(float v) { v += xor_swz<1>(v); v += xor_swz<2>(v); v += xor_swz<4>(v); v += xor_swz<8>(v); v += xor_swz<16>(v); return half_sum(v); }
__device__ __forceinline__ float bcast(float v, int srclane) { return __int_as_float(__builtin_amdgcn_readlane(__float_as_int(v), srclane)); }
__device__ __forceinline__ int vzero() { int z = 0; asm volatile("" : "+v"(z)); return z; }
__device__ __forceinline__ float sigmoidf_(float z) { return __builtin_amdgcn_rcpf(1.0f + __builtin_amdgcn_exp2f(-1.4426950408889634f * z)); }
__device__ __forceinline__ float gelu_tanh(float y) { const float z = 0.7978845608028654f * (y + 0.044715f * y * y * y); const float t = 1.0f - 2.0f * __builtin_amdgcn_rcpf(1.0f + __builtin_amdgcn_exp2f(2.885390081777927f * z)); return 0.5f * y * (1.0f + t); }

__device__ __forceinline__ int lane_id();
#define XB_TMO      128
#define XB_XCNT(j)  (256  + 64 * (j))
#define XB_XSUB(j)  (1280 + 64 * (j))
#define XB_XGEN(j)  (2304 + 64 * (j))
#define XB_TOP      3328
#define XB_TOPGEN   3392
#define XCD_BAR_WORDS 3456
#define XB_SPIN_CAP (1u << 18)
typedef GAS unsigned gu32;
__device__ __forceinline__ unsigned xb_ld(gu32* p)              { return __hip_atomic_load(p, __ATOMIC_RELAXED, __HIP_MEMORY_SCOPE_AGENT); }
__device__ __forceinline__ unsigned xb_add(gu32* p, unsigned v) { return __hip_atomic_fetch_add(p, v, __ATOMIC_RELAXED, __HIP_MEMORY_SCOPE_AGENT); }
__device__ __forceinline__ unsigned xb_xcc_id() { return (unsigned)__builtin_amdgcn_s_getreg((3 << 11) | 20) & 0xFu; }
#define XB_SPIN(cond, bar) do { unsigned _sp = 0; while (cond) { __builtin_amdgcn_s_sleep(1); \
    if ((++_sp & 255u) == 0u) { if (xb_ld(&(bar)[XB_TMO])) break; if (_sp > XB_SPIN_CAP) { (void)xb_add(&(bar)[XB_TMO], 1u); break; } } } } while (0)
struct XcdBarrier { gu32* bar; unsigned x; volatile LAS unsigned* st; };
__device__ __forceinline__ XcdBarrier xcd_barrier_post(gu32* bar, volatile LAS unsigned* st) {
    XcdBarrier b; b.bar = bar; b.x = xb_xcc_id(); b.st = st;
    if (threadIdx.x == 0) (void)xb_add(&bar[XB_XCNT(b.x)], 1u);
    return b;
}
__device__ __forceinline__ void xcd_barrier_complete(gu32* bar, unsigned x, unsigned& nloc, unsigned& nx) {
    const unsigned G = gridDim.x * gridDim.y * gridDim.z;
    unsigned sum, cnt, mine, sp = 0u;
    for (;;) {
        sum = 0u; cnt = 0u; mine = 0u;
#pragma unroll
        for (unsigned j = 0; j < 16; ++j) { const unsigned c = xb_ld(&bar[XB_XCNT(j)]); sum += c; cnt += (c > 0u) ? 1u : 0u; mine = (j == x) ? c : mine; }
        if (sum == G) break;
        __builtin_amdgcn_s_sleep(1);
        if ((++sp & 255u) == 0u) { if (xb_ld(&bar[XB_TMO])) break; if (sp > XB_SPIN_CAP) { (void)xb_add(&bar[XB_TMO], 1u); break; } }
    }
    nloc = mine > 0u ? mine : 1u; nx = cnt > 0u ? cnt : 1u;
}
template <bool FIRST>
__device__ __forceinline__ void xcd_barrier(const XcdBarrier& b, const int wave) {
    asm volatile("s_waitcnt vmcnt(0)" ::: "memory");
    __syncthreads();
    if (wave == 0 && lane_id() == 0) {
        gu32* bar = b.bar; unsigned bx = b.x;
        asm volatile("" : "+s"(bar), "+s"(bx));
        __builtin_amdgcn_s_waitcnt(0);
        unsigned nloc = b.st[0], nx = b.st[1];
        if (FIRST) { if (nloc == 0u) { xcd_barrier_complete(bar, bx, nloc, nx); b.st[0] = nloc; b.st[1] = nx; } }
        const unsigned old = xb_add(&bar[XB_XSUB(bx)], 1u);
        const unsigned gen = old / nloc;
        if (old + 1u == (gen + 1u) * nloc) {
            __builtin_amdgcn_fence(__ATOMIC_RELEASE, "agent");
            asm volatile("s_waitcnt vmcnt(0)" ::: "memory");
            const unsigned og = xb_add(&bar[XB_TOP], 1u);
            const unsigned tg = og / nx;
            if (og + 1u == (tg + 1u) * nx) xb_add(&bar[XB_TOPGEN], 1u);
            else XB_SPIN(xb_ld(&bar[XB_TOPGEN]) == tg, bar);
            __builtin_amdgcn_fence(__ATOMIC_ACQUIRE, "agent");
            xb_add(&bar[XB_XGEN(bx)], 1u);
            asm volatile("s_waitcnt vmcnt(0)" ::: "memory");
        } else {
            XB_SPIN(xb_ld(&bar[XB_XGEN(bx)]) == gen, bar);
            __builtin_amdgcn_fence(__ATOMIC_ACQUIRE, "agent");
            asm volatile("s_waitcnt vmcnt(0)" ::: "memory");
        }
    }
    __syncthreads();
}

namespace pg8 {
constexpr int BM = 256, BK = 64, HALF = 128, HTB = HALF * BK * 2, STAGE_BYTES = 8 * HTB, NXCD = 8, WGM = 8;
__host__ __device__ __forceinline__ int lds_byte(int r, int c) { const int st = (r >> 4) * 2 + (c >> 5), rr = r & 15, cc = c & 31, ob = rr * 64 + cc * 2; return st * 1024 + (ob ^ (((ob >> 9) & 1) << 5)); }
__host__ __device__ __forceinline__ void stage_rc(int b, int& R, int& C) { const int st = b / 1024, sb = b % 1024, swz = sb ^ (((sb >> 9) & 1) << 5); R = (st >> 1) * 16 + swz / 64; C = (st & 1) * 32 + (swz % 64) / 2; }
__host__ __device__ __forceinline__ int perm32(int rho) { const int n = rho >> 4, i = rho & 15; return 8 * (i >> 2) + 4 * n + (i & 3); }

struct Unit { int pm, pn, ui; const bf16_t* A; const bf16_t* Bt; };

template <class Epi, class Sched, bool GATHER, bool ALIGN_EPI, bool FP8 = false>
__device__ __forceinline__ void gemm_phase(LAS unsigned char* lds, const int wid, const int K, const int lda, const Sched& S, const Epi& E, volatile LAS const unsigned* gtab) {
    int lane = lane_id(); asm volatile("" : "+v"(lane));
    const int tid = wid * 64 + lane, wr = wid >> 2, wc = wid & 3, fr = lane & 15, fq = lane >> 4;
    const int nt = K / BK;
    unsigned voffA[2], voffB[2]; int Rr[2];
#pragma unroll
    for (int i = 0; i < 2; ++i) { int R, C; stage_rc(tid * 16 + i * 8192, R, C); const int Rb = Epi::PERM ? ((R & ~31) + perm32(R & 31)) : R;
        Rr[i] = R; voffA[i] = GATHER ? 0u : (unsigned)(R * lda + C) * 2u; voffB[i] = (unsigned)(Rb * K + C) * 2u; }
    const size_t hstepB = (size_t)HALF * K * 2, hstepA = (size_t)HALF * lda * 2;
    const unsigned rowb = (unsigned)lda * 2u;
    const unsigned ldsw = (unsigned)wid * 1024u;
    const int aoff = lds_byte(wr * 64 + fr, fq * 8), boff = lds_byte(wc * 32 + fr, fq * 8);
#define PG8_SA(b, h) (((b) * 2 + (h)) * HTB)
#define PG8_SB(b, h) ((4 + (b) * 2 + (h)) * HTB)
#define PG8_STAGE(bufoff, gbase, voff) do { _Pragma("unroll") for (int _i = 0; _i < 2; ++_i) \
        __builtin_amdgcn_global_load_lds((const unsigned*)((const char*)(gbase) + (voff)[_i]), (LAS unsigned*)(lds + (bufoff) + ldsw + _i * 8192), 16, 0, 0); } while (0)
#define PG8_GTOK(dst, uidx, half) do { if constexpr (GATHER) { _Pragma("unroll") for (int _i = 0; _i < 2; ++_i) { int R_, C_, t_ = tid; asm volatile("" : "+v"(t_)); stage_rc(t_ * 16 + _i * 8192, R_, C_);     \
        dst[_i] = gtab[(uidx) * 256 + (half) * 128 + R_] * rowb + (unsigned)C_ * 2u; } } } while (0)
#define PG8_LDA(dst, b, h) do { if constexpr (FP8) { _Pragma("unroll") for (int m = 0; m < 4; ++m) dst##8[m] = __builtin_shufflevector(*(const LAS v4i_*)(lds + PG8_SA(b, h) + aoff + m * 2048), *(const LAS v4i_*)(lds + PG8_SA(b, h) + aoff + m * 2048 + 1024), 0, 1, 2, 3, 4, 5, 6, 7); } \
        else { _Pragma("unroll") for (int m = 0; m < 4; ++m) _Pragma("unroll") for (int k = 0; k < 2; ++k) dst[m][k] = *(const LAS bf16x8*)(lds + PG8_SA(b, h) + aoff + m * 2048 + k * 1024); } } while (0)
#define PG8_LDB(dst, b, h) do { if constexpr (FP8) { _Pragma("unroll") for (int n = 0; n < 2; ++n) dst##8[n] = __builtin_shufflevector(*(const LAS v4i_*)(lds + PG8_SB(b, h) + boff + n * 2048), *(const LAS v4i_*)(lds + PG8_SB(b, h) + boff + n * 2048 + 1024), 0, 1, 2, 3, 4, 5, 6, 7); } \
        else { _Pragma("unroll") for (int n = 0; n < 2; ++n) _Pragma("unroll") for (int k = 0; k < 2; ++k) dst[n][k] = *(const LAS bf16x8*)(lds + PG8_SB(b, h) + boff + n * 2048 + k * 1024); } } while (0)
#define PG8_MMA(ai, bj, At, Bt) do { __builtin_amdgcn_s_setprio(1); _Pragma("unroll") for (int m = 0; m < 4; ++m) _Pragma("unroll") for (int n = 0; n < 2; ++n) { \
        if constexpr (FP8) acc[ai][bj][m][n] = __builtin_amdgcn_mfma_scale_f32_16x16x128_f8f6f4(Bt##8[n], At##8[m], acc[ai][bj][m][n], 0, 0, 0, 0x7f7f7f7f, 0, 0x7f7f7f7f); \
        else { _Pragma("unroll") for (int k = 0; k < 2; ++k) acc[ai][bj][m][n] = __builtin_amdgcn_mfma_f32_16x16x32_bf16(Bt[n][k], At[m][k], acc[ai][bj][m][n], 0, 0, 0); } } \
        __builtin_amdgcn_s_setprio(0); } while (0)
#define PG8_WAIT_V(n) asm volatile("s_waitcnt vmcnt(" #n ")" ::: "memory")
#define PG8_WAIT_L(n) asm volatile("s_waitcnt lgkmcnt(" #n ")" ::: "memory")
#define PG8_BAR __builtin_amdgcn_s_barrier()
#define PG8_SCHED __builtin_amdgcn_sched_barrier(0)
    Unit cur, nxt; int ui = 0;
    if (!S.next(0, cur)) return;
    f32x4 acc[2][2][4][2];
#pragma unroll
    for (int a = 0; a < 2; ++a)
#pragma unroll
        for (int b = 0; b < 2; ++b)
#pragma unroll
            for (int m = 0; m < 4; ++m)
#pragma unroll
                for (int n = 0; n < 2; ++n) acc[a][b][m][n] = (f32x4){0.f, 0.f, 0.f, 0.f};
    typedef int v4i_ __attribute__((ext_vector_type(4))); typedef int v8i_ __attribute__((ext_vector_type(8)));
    bf16x8 At[4][2], B0[2][2], B1[2][2];
    v8i_ At8[4], B08[2], B18[2];
    unsigned go[2];
    const char* cA = (const char*)cur.A; const char* cB = (const char*)cur.Bt;
    PG8_STAGE(PG8_SB(0, 0), cB, voffB); PG8_STAGE(PG8_SB(0, 1), cB + hstepB, voffB);
    if constexpr (GATHER) { PG8_GTOK(go, 0, 0); PG8_STAGE(PG8_SA(0, 0), cA, go); PG8_GTOK(go, 0, 1); PG8_STAGE(PG8_SA(0, 1), cA, go); }
    else { PG8_STAGE(PG8_SA(0, 0), cA, voffA); PG8_STAGE(PG8_SA(0, 1), cA + hstepA, voffA); }
    if (wr == 1) PG8_BAR;
    PG8_WAIT_V(2); PG8_BAR;
    PG8_STAGE(PG8_SB(1, 0), cB + 128, voffB);
    if constexpr (GATHER) { PG8_GTOK(go, 0, 0); PG8_STAGE(PG8_SA(1, 0), cA + 128, go); } else { PG8_STAGE(PG8_SA(1, 0), cA + 128, voffA); }
    PG8_STAGE(PG8_SB(1, 1), cB + hstepB + 128, voffB);
    PG8_WAIT_V(6); PG8_BAR;
    for (;;) {
        const bool has_next = S.next(ui + 1, nxt);
        const char* nA = has_next ? (const char*)nxt.A : cA; const char* nB = has_next ? (const char*)nxt.Bt : cB;
        const int nui = has_next ? ui + 1 : ui;
#pragma nounroll
        for (int t = 0; t < nt; t += 2) {
            const bool last = (t == nt - 2);
            const char* a1 = cA + (size_t)(t + 1) * 128;
            const char* a2 = last ? nA : cA + (size_t)(t + 2) * 128; const char* b2 = last ? nB : cB + (size_t)(t + 2) * 128;
            const char* a3 = a2 + 128; const char* b3 = b2 + 128;
            const int u2 = last ? nui : ui;
            PG8_GTOK(go, ui, 1);
            PG8_LDB(B0, 0, 0); PG8_LDB(B1, 0, 1); PG8_SCHED; PG8_LDA(At, 0, 0);
            if constexpr (GATHER) { PG8_STAGE(PG8_SA(1, 1), a1, go); } else { PG8_STAGE(PG8_SA(1, 1), a1 + hstepA, voffA); }
            PG8_WAIT_V(8); PG8_WAIT_L(0); PG8_BAR; PG8_MMA(0, 0, At, B0); PG8_MMA(0, 1, At, B1); PG8_BAR; PG8_SCHED;
            PG8_GTOK(go, u2, 0);
            PG8_LDA(At, 0, 1); PG8_STAGE(PG8_SB(0, 0), b2, voffB); PG8_STAGE(PG8_SB(0, 1), b2 + hstepB, voffB);
            if constexpr (GATHER) { PG8_STAGE(PG8_SA(0, 0), a2, go); } else { PG8_STAGE(PG8_SA(0, 0), a2, voffA); }
            PG8_WAIT_V(8); PG8_WAIT_L(0); PG8_BAR; PG8_MMA(1, 0, At, B0); PG8_MMA(1, 1, At, B1); PG8_BAR; PG8_SCHED;
            PG8_GTOK(go, u2, 1);
            PG8_LDB(B0, 1, 0); PG8_LDB(B1, 1, 1); PG8_SCHED; PG8_LDA(At, 1, 0);
            if constexpr (GATHER) { PG8_STAGE(PG8_SA(0, 1), a2, go); } else { PG8_STAGE(PG8_SA(0, 1), a2 + hstepA, voffA); }
            PG8_WAIT_V(8); PG8_WAIT_L(0); PG8_BAR; PG8_MMA(0, 0, At, B0); PG8_MMA(0, 1, At, B1); PG8_BAR; PG8_SCHED;
            PG8_GTOK(go, u2, 0);
            PG8_LDA(At, 1, 1); PG8_STAGE(PG8_SB(1, 0), b3, voffB); PG8_STAGE(PG8_SB(1, 1), b3 + hstepB, voffB);
            if constexpr (GATHER) { PG8_STAGE(PG8_SA(1, 0), a3, go); } else { PG8_STAGE(PG8_SA(1, 0), a3, voffA); }
            PG8_WAIT_V(8); PG8_WAIT_L(0); PG8_BAR; PG8_MMA(1, 0, At, B0); PG8_MMA(1, 1, At, B1); PG8_BAR; PG8_SCHED;
        }
        if constexpr (ALIGN_EPI) { if (wr == 0) PG8_BAR; }
        E(acc, cur, wr, wc, fr, fq, lds);
        if (!has_next) break;
#pragma unroll
        for (int a = 0; a < 2; ++a)
#pragma unroll
            for (int b = 0; b < 2; ++b)
#pragma unroll
                for (int m = 0; m < 4; ++m)
#pragma unroll
                    for (int n = 0; n < 2; ++n) acc[a][b][m][n] = (f32x4){0.f, 0.f, 0.f, 0.f};
        cur = nxt; cA = nA; cB = nB; ++ui;
        if constexpr (ALIGN_EPI) { if (wr == 1) PG8_BAR; }
    }
    PG8_WAIT_V(0);
    if constexpr (!ALIGN_EPI) { if (wr == 0) PG8_BAR; }
    PG8_BAR;
#undef PG8_SA
#undef PG8_SB
#undef PG8_STAGE
#undef PG8_GTOK
#undef PG8_LDA
#undef PG8_LDB
#undef PG8_MMA
#undef PG8_WAIT_V
#undef PG8_WAIT_L
#undef PG8_BAR
#undef PG8_SCHED
}

struct DenseOrder {
    int nM, nN, nwg, G, c, K, lda; const bf16_t* A; const bf16_t* Bt; bool via_table = false;
    __device__ __forceinline__ void init(int M, int N, int K_, int lda_, int G_, int c_, const bf16_t* A_, const bf16_t* Bt_) { nM = M / BM; nN = N / BM; nwg = nM * nN; G = G_; c = c_; K = K_; lda = lda_; A = A_; Bt = Bt_; }
    __device__ __forceinline__ bool next(int i, Unit& u) const {
        const long L = (long)i * G + c; if (L >= nwg) return false;
        int wgid = (int)L; { const int q = nwg / NXCD, r = nwg % NXCD, xcd = wgid % NXCD, off = wgid / NXCD; wgid = (xcd < r ? xcd * (q + 1) : r * (q + 1) + (xcd - r) * q) + off; }
        const int nig = WGM * nN, gid = wgid / nig, fm = gid * WGM, gsz = (nM - fm) < WGM ? (nM - fm) : WGM;
        u.pm = fm + ((wgid % nig) % gsz); u.pn = (wgid % nig) / gsz; u.ui = i; u.A = via_table ? A : A + (size_t)u.pm * BM * lda; u.Bt = Bt + (size_t)u.pn * BM * K; return true;
    }
};
}

struct Params {
    const float* x; const float* c; const float* norm_mix; const float* norm_ffn; const float* w_ada; const float* b_ada;
    const float* attn_w_qkv; const float* attn_q_gain; const float* attn_k_gain; const float* attn_sinks; const float* attn_w_o;
    const float* ssm_w_in; const float* ssm_lam_re; const float* ssm_lam_im; const float* ssm_log_dt; const float* ssm_b_re; const float* ssm_b_im;
    const float* ssm_c_re; const float* ssm_c_im; const float* ssm_d; const float* ssm_w_glu;
    const float* moe_w_group; const float* moe_b_group; const float* moe_w_expert; const float* moe_b_expert;
    const float* moe_w_gate; const float* moe_w_up; const float* moe_w_down;
    float* out; unsigned char* ws;
};

__device__ __forceinline__ Params load_params() {
    Params p{};
#if defined(__HIP_DEVICE_COMPILE__)
    typedef GAS char* gptr_t;
    typedef __attribute__((address_space(4))) const gptr_t* KP;
    KP kp = (KP)__builtin_amdgcn_kernarg_segment_ptr();
    asm volatile("" : "+s"(kp));
    p.x = (const float*)kp[0]; p.c = (const float*)kp[1]; p.norm_mix = (const float*)kp[2]; p.norm_ffn = (const float*)kp[3]; p.w_ada = (const float*)kp[4]; p.b_ada = (const float*)kp[5];
    p.attn_w_qkv = (const float*)kp[6]; p.attn_q_gain = (const float*)kp[7]; p.attn_k_gain = (const float*)kp[8]; p.attn_sinks = (const float*)kp[9]; p.attn_w_o = (const float*)kp[10];
    p.ssm_w_in = (const float*)kp[11]; p.ssm_lam_re = (const float*)kp[12]; p.ssm_lam_im = (const float*)kp[13]; p.ssm_log_dt = (const float*)kp[14]; p.ssm_b_re = (const float*)kp[15]; p.ssm_b_im = (const float*)kp[16];
    p.ssm_c_re = (const float*)kp[17]; p.ssm_c_im = (const float*)kp[18]; p.ssm_d = (const float*)kp[19]; p.ssm_w_glu = (const float*)kp[20];
    p.moe_w_group = (const float*)kp[21]; p.moe_b_group = (const float*)kp[22]; p.moe_w_expert = (const float*)kp[23]; p.moe_b_expert = (const float*)kp[24];
    p.moe_w_gate = (const float*)kp[25]; p.moe_w_up = (const float*)kp[26]; p.moe_w_down = (const float*)kp[27];
    p.out = (float*)kp[28]; p.ws = (unsigned char*)kp[29];
#endif
    return p;
}
__device__ __forceinline__ int opaque_v(int v) { asm volatile("" : "+v"(v)); return v; }
__device__ __forceinline__ int lane_id() { int l; asm volatile("v_mbcnt_lo_u32_b32 %0, -1, 0\n\tv_mbcnt_hi_u32_b32 %0, -1, %0" : "=v"(l)); return l; }

using pg8::Unit;
typedef f32x4 AccT[2][2][4][2];

struct EpiQKV {
    static constexpr bool PERM = true;
    bf16_t* Q; bf16_t* Kb; bf16_t* Vt;
    __device__ __forceinline__ void operator()(const AccT& acc, const Unit& u, int wr, int wc, int fr, int fq, LAS unsigned char*) const {
        const int row0 = u.pm * 256 + wr * 64 + fr, cl = wc * 32 + 8 * fq;
#pragma unroll
        for (int ai = 0; ai < 2; ++ai)
#pragma unroll
            for (int m = 0; m < 4; ++m) {
                const int row = row0 + ai * 128 + m * 16;
#pragma unroll
                for (int bj = 0; bj < 2; ++bj) {
                    const f32x4 v0 = acc[ai][bj][m][0], v1 = acc[ai][bj][m][1];
                    u32x4 w; w.x = cvt_pk_bf16(v0[0], v0[1]); w.y = cvt_pk_bf16(v0[2], v0[3]); w.z = cvt_pk_bf16(v1[0], v1[1]); w.w = cvt_pk_bf16(v1[2], v1[3]);
                    const int col = bj * 128 + cl;
                    if (u.pn < 4) { *(u32x4*)((char*)Q + (unsigned)(row * 1024 + u.pn * 256 + col) * 2u) = w; }
                    else if (u.pn == 4) { *(u32x4*)((char*)Kb + (unsigned)(row * 256 + col) * 2u) = w; }
                    else {
                        const int b = row >> 11, t0 = row & 2047, t = (t0 & ~31) | ((((t0 >> 2) & 1) << 4) + (((t0 >> 3) & 3) << 2) + (t0 & 3)), kvh = col >> 6, d0 = col & 63;
                        bf16_t* vp = (bf16_t*)((char*)Vt + (unsigned)((((b * 4 + kvh) * 64 + d0)) * 2048 + t) * 2u);
                        vp[0 * 2048] = (bf16_t)(w.x & 0xffffu); vp[1 * 2048] = (bf16_t)(w.x >> 16);
                        vp[2 * 2048] = (bf16_t)(w.y & 0xffffu); vp[3 * 2048] = (bf16_t)(w.y >> 16);
                        vp[4 * 2048] = (bf16_t)(w.z & 0xffffu); vp[5 * 2048] = (bf16_t)(w.z >> 16);
                        vp[6 * 2048] = (bf16_t)(w.w & 0xffffu); vp[7 * 2048] = (bf16_t)(w.w >> 16);
                    }
                }
            }
    }
};
struct EpiDelta {
    static constexpr bool PERM = true;
    bf16_t* D; const float* gate_l;
    __device__ __forceinline__ void operator()(const AccT& acc, const Unit& u, int wr, int wc, int fr, int fq, LAS unsigned char*) const {
        const int row0 = u.pm * 256 + wr * 64 + fr, col0 = u.pn * 256 + wc * 32 + 8 * fq;
        const float* gp = (const float*)((const char*)gate_l + (unsigned)((u.pm >> 3) * ADA + col0) * 4u);
        f32x4 gv[2][2];
#pragma unroll
        for (int bj = 0; bj < 2; ++bj)
#pragma unroll
            for (int n = 0; n < 2; ++n) gv[bj][n] = *(const f32x4*)(gp + bj * 128 + n * 4) * (1.0f / 256.0f);
#pragma unroll
        for (int ai = 0; ai < 2; ++ai)
#pragma unroll
            for (int m = 0; m < 4; ++m) { bf16_t* rowp = (bf16_t*)((char*)D + (unsigned)((row0 + ai * 128 + m * 16) * 1024 + col0) * 2u);
#pragma unroll
                for (int bj = 0; bj < 2; ++bj) { const f32x4 v0 = acc[ai][bj][m][0] * gv[bj][0], v1 = acc[ai][bj][m][1] * gv[bj][1];
                    u32x4 w; w.x = cvt_pk_bf16(v0[0], v0[1]); w.y = cvt_pk_bf16(v0[2], v0[3]); w.z = cvt_pk_bf16(v1[0], v1[1]); w.w = cvt_pk_bf16(v1[2], v1[3]);
                    *(u32x4*)(rowp + bj * 128) = w; } }
    }
};
struct EpiGLU {
    static constexpr bool PERM = true;
    bf16_t* D; const float* gate_l;
    __device__ __forceinline__ void operator()(const AccT& acc, const Unit& u, int wr, int wc, int fr, int fq, LAS unsigned char*) const {
        int pm_ = u.pm; asm volatile("" : "+s"(pm_));
        const int row0 = pm_ * 256 + wr * 64 + fr, col0 = u.pn * 128 + wc * 32 + 8 * fq;
        const float* gp = (const float*)((const char*)gate_l + (unsigned)((pm_ >> 3) * ADA + col0) * 4u);
        f32x4 gv[2];
#pragma unroll
        for (int n = 0; n < 2; ++n) gv[n] = *(const f32x4*)(gp + n * 4);
#pragma unroll
        for (int ai = 0; ai < 2; ++ai)
#pragma unroll
            for (int m = 0; m < 4; ++m) { float o[8];
#pragma unroll
                for (int n = 0; n < 2; ++n)
#pragma unroll
                    for (int j = 0; j < 4; ++j) o[n * 4 + j] = gv[n][j] * (acc[ai][0][m][n][j] * 0.0625f) * sigmoidf_(acc[ai][1][m][n][j] * 0.0625f);
                u32x4 w; w.x = cvt_pk_bf16(o[0], o[1]); w.y = cvt_pk_bf16(o[2], o[3]); w.z = cvt_pk_bf16(o[4], o[5]); w.w = cvt_pk_bf16(o[6], o[7]);
                *(u32x4*)((char*)D + (unsigned)((row0 + ai * 128 + m * 16) * 1024 + col0) * 2u) = w; }
    }
};
struct EpiU {
    static constexpr bool PERM = true;
    bf16_t* US;
    __device__ __forceinline__ void operator()(const AccT& acc, const Unit& u, int wr, int wc, int fr, int fq, LAS unsigned char*) const {
        const int row0 = u.pm * 256 + wr * 64 + fr;
#pragma unroll
        for (int ai = 0; ai < 2; ++ai)
#pragma unroll
            for (int m = 0; m < 4; ++m) {
                const int row = row0 + ai * 128 + m * 16, b = row >> 11, t = row & 2047;
#pragma unroll
                for (int bj = 0; bj < 2; ++bj) {
                    const f32x4 v0 = acc[ai][bj][m][0] * 0.0625f, v1 = acc[ai][bj][m][1] * 0.0625f;
                    u32x4 w; w.x = cvt_pk_bf16(v0[0], v0[1]); w.y = cvt_pk_bf16(v0[2], v0[3]); w.z = cvt_pk_bf16(v1[0], v1[1]); w.w = cvt_pk_bf16(v1[2], v1[3]);
                    const int c0 = u.pn * 256 + bj * 128 + wc * 32 + 8 * fq, g = c0 >> 4, ci0 = c0 & 15;
                    *(u32x4*)((char*)US + (unsigned)((g * 2048 + b * 128 + (t >> 4)) * 384 + (t & 15) * 16 + ci0) * 2u) = w;
                }
            }
    }
};
struct EpiSwiGLU {
    static constexpr bool PERM = true;
    bf16_t* HID;
    __device__ __forceinline__ void operator()(const AccT& acc, const Unit& u, int wr, int wc, int fr, int fq, LAS unsigned char*) const {
        const int row0 = u.pm * 256 + wr * 64 + fr, col0 = u.pn * 128 + wc * 32 + 8 * fq;
#pragma unroll
        for (int ai = 0; ai < 2; ++ai)
#pragma unroll
            for (int m = 0; m < 4; ++m) {
                float h[8];
#pragma unroll
                for (int n = 0; n < 2; ++n)
#pragma unroll
                    for (int j = 0; j < 4; ++j) { const float g = acc[ai][0][m][n][j] * 0.0625f, up = acc[ai][1][m][n][j] * 0.0625f; h[n * 4 + j] = g * sigmoidf_(g) * up; }
                u32x2 w; w.x = pack4_fp8_raw(h[0] * 8.f, h[1] * 8.f, h[2] * 8.f, h[3] * 8.f); w.y = pack4_fp8_raw(h[4] * 8.f, h[5] * 8.f, h[6] * 8.f, h[7] * 8.f);
                *(u32x2*)((unsigned char*)HID + (unsigned)((row0 + ai * 128 + m * 16) * 256 + col0)) = w;
            }
    }
};
struct EpiDown {
    static constexpr bool PERM = true;
    bf16_t* Y;
    __device__ __forceinline__ void operator()(const AccT& acc, const Unit& u, int wr, int wc, int fr, int fq, LAS unsigned char* lds) const {
        volatile LAS const unsigned* tab = (volatile LAS const unsigned*)(lds + MOE_TAB + 256) + u.ui * 512;
        const int col0 = u.pn * 256 + wc * 32 + 8 * fq;
#pragma unroll
        for (int ai = 0; ai < 2; ++ai)
#pragma unroll
            for (int m = 0; m < 4; ++m) {
                const int ti = (ai * 128 + wr * 64 + m * 16 + fr) * 2;
                u32x2 ent; ent.x = tab[ti]; ent.y = tab[ti + 1];
                if (ent.x != 0xffffffffu) {
                    const float gate = __uint_as_float(ent.y) * (1.0f / 128.0f);
                    unsigned char* dst = (unsigned char*)Y + (((ent.x & 1u) * (unsigned)NTOK + (ent.x >> 1)) * 1024u + (unsigned)col0);
#pragma unroll
                    for (int bj = 0; bj < 2; ++bj) {
                        const f32x4 v0 = acc[ai][bj][m][0] * gate, v1 = acc[ai][bj][m][1] * gate;
                        u32x2 w; w.x = pack4_fp8(v0[0], v0[1], v0[2], v0[3]); w.y = pack4_fp8(v1[0], v1[1], v1[2], v1[3]);
                        *(u32x2*)(dst + bj * 128) = w;
                    }
                }
            }
    }
};

struct SsmOrder {
    int G, c, K; const bf16_t* US; const bf16_t* Bm; size_t bstride;
    __device__ __forceinline__ bool next(int i, Unit& u) const {
        const int L = i * G + c; if (L >= SG * 8) return false;
        u.pm = L; u.pn = 0; u.ui = i; u.A = US + (size_t)L * 256 * 384; u.Bt = Bm + (size_t)(L >> 3) * bstride; return true;
    }
};
struct EpiW {
    static constexpr bool PERM = true;
    bf16_t* W;
    __device__ __forceinline__ void operator()(const AccT& acc, const Unit& u, int wr, int wc, int fr, int fq, LAS unsigned char*) const {
        const int row0 = u.pm * 256 + wr * 64 + fr, col0 = wc * 32 + 8 * fq;
#pragma unroll
        for (int ai = 0; ai < 2; ++ai)
#pragma unroll
            for (int m = 0; m < 4; ++m) { const f32x4 v0 = acc[ai][0][m][0], v1 = acc[ai][0][m][1];
                u32x4 w; w.x = cvt_pk_bf16(v0[0], v0[1]); w.y = cvt_pk_bf16(v0[2], v0[3]); w.z = cvt_pk_bf16(v1[0], v1[1]); w.w = cvt_pk_bf16(v1[2], v1[3]);
                *(u32x4*)((char*)W + (unsigned)((row0 + ai * 128 + m * 16) * 128 + col0) * 2u) = w; }
    }
};
struct EpiY {
    static constexpr bool PERM = true;
    bf16_t* YG;
    __device__ __forceinline__ void operator()(const AccT& acc, const Unit& u, int wr, int wc, int fr, int fq, LAS unsigned char*) const {
        const int g = u.pm >> 3, rowg0 = (u.pm & 7) * 256 + wr * 64 + fr;
#pragma unroll
        for (int ai = 0; ai < 2; ++ai)
#pragma unroll
            for (int m = 0; m < 4; ++m) {
                const int rowg = rowg0 + ai * 128 + m * 16, b = rowg >> 7, k = rowg & 127;
#pragma unroll
                for (int bj = 0; bj < 2; ++bj) {
                    const f32x4 v0 = acc[ai][bj][m][0], v1 = acc[ai][bj][m][1];
                    u32x2 w; w.x = pack4_fp8_raw(gelu_tanh(v0[0]), gelu_tanh(v0[1]), gelu_tanh(v0[2]), gelu_tanh(v0[3])); w.y = pack4_fp8_raw(gelu_tanh(v1[0]), gelu_tanh(v1[1]), gelu_tanh(v1[2]), gelu_tanh(v1[3]));
                    const int col = bj * 128 + wc * 32 + 8 * fq, t = col >> 4, co0 = col & 15;
                    *(u32x2*)((unsigned char*)YG + (unsigned)((b * 2048 + 16 * k + t) * 1024 + g * 16 + co0)) = w;
                }
            }
    }
};

struct MoeOrder {
    LAS const int* utab; int nunits, K, dense_lda; const bf16_t* A; const bf16_t* Wl; size_t boff;
    __device__ __forceinline__ bool next(int i, Unit& u) const {
        if (i >= nunits) return false;
        const LAS int* t = utab + i * 8;
        u.pm = __builtin_amdgcn_readfirstlane(t[0]); u.pn = __builtin_amdgcn_readfirstlane(t[1]); const int e = __builtin_amdgcn_readfirstlane(t[2]); u.ui = i;
        u.A = A + (size_t)u.pm * 256 * dense_lda; u.Bt = Wl + (size_t)e * 786432 + boff + (size_t)u.pn * 256 * K; return true;
    }
};

struct Ctx { LAS unsigned char* lds; int wave, vcu, G, gw, NGW; };

constexpr int CI_QKV = 16 * 6, CI_SQ = 16 * 4, CI_GLU = 16 * 8, CI_ATT = CI_QKV + CI_SQ, CI_SSM = CI_SQ + CI_GLU, CI_EXP = 48;
constexpr int CI_DENSE = 2 * CI_ATT + 2 * CI_SSM;
__device__ __forceinline__ void conv_range(const Params& p, const Ctx& cx, const int tid_, const int cbeg, const int cend) {
    f32x4 preA[8], preB[8];
    const float* srcA = nullptr; bf16_t* dstA = nullptr; int KA = 0, NA = 0, k0A = 0, n0A = 0, modeA = 0;
    const float* srcB = nullptr; bf16_t* dstB = nullptr; int KB = 0, NB_ = 0, k0B = 0, n0B = 0, modeB = 0;
#define CV_DECODE(it_, src, dst, K, N, k0, n0, mode) do { int r = (it_); \
        if (r < 2 * CI_ATT) { const int i = r / CI_ATT; int q = r % CI_ATT; bf16_t* base = (bf16_t*)(p.ws + WS_WATT + (size_t)i * 5 * MiB); \
            if (q < CI_QKV) { src = p.attn_w_qkv + (size_t)i * DM * QKVD; dst = base; K = DM; N = QKVD; k0 = (q / 6) * 64; n0 = (q % 6) * 256; mode = 0; } \
            else { q -= CI_QKV; src = p.attn_w_o + (size_t)i * DM * DM; dst = base + 3 * MiB / 2; K = DM; N = DM; k0 = (q / 4) * 64; n0 = (q % 4) * 256; mode = 4; } } \
        else if ((r -= 2 * CI_ATT) < 2 * CI_SSM) { const int i = r / CI_SSM; int q = r % CI_SSM; bf16_t* base = (bf16_t*)(p.ws + WS_WSSM + (size_t)i * 6 * MiB); \
            if (q < CI_SQ) { src = p.ssm_w_in + (size_t)i * DM * DM; dst = base; K = DM; N = DM; k0 = (q / 4) * 64; n0 = (q % 4) * 256; mode = 4; } \
            else { q -= CI_SQ; src = p.ssm_w_glu + (size_t)i * DM * 2 * DM; dst = base + 2 * MiB / 2; K = DM; N = 2 * DM; k0 = (q / 8) * 64; n0 = (q % 8) * 256; mode = 1; } } \
        else { r -= 2 * CI_SSM; const int le = r / CI_EXP, q = r % CI_EXP, which = q >> 4, sub = q & 15; bf16_t* base = (bf16_t*)(p.ws + WS_WMOE + (size_t)le * 3 * MiB / 2); \
            if (which < 2) { src = (which ? p.moe_w_up : p.moe_w_gate) + (size_t)le * DM * FE; dst = base; K = DM; N = FE; k0 = sub * 64; n0 = 0; mode = 2 + which; } \
            else { src = p.moe_w_down + (size_t)le * FE * DM; dst = base + MiB / 2; K = FE; N = DM; k0 = (sub >> 2) * 64; n0 = (sub & 3) * 256; mode = 5; } } } while (0)
#define CV_LOAD(pre, src, N, k0, n0) do { _Pragma("unroll") for (int i_ = 0; i_ < 8; ++i_) { const int idx = tid_ + 512 * i_; pre[i_] = *(const f32x4*)(src + (size_t)(k0 + (idx >> 6)) * N + n0 + 4 * (idx & 63)); } } while (0)
#define CV_ITEM(pre, src, dst, K, N, k0, n0, mode, bufi, nxt_) do { \
        LAS float* Lt = (LAS float*)(cx.lds + (bufi) * 66560); \
        _Pragma("unroll") for (int i_ = 0; i_ < 8; ++i_) { const int idx = tid_ + 512 * i_; *(LAS f32x4*)(Lt + (idx >> 6) * 260 + 4 * (idx & 63)) = pre[i_]; } \
        bf16_t* cdst = dst; const int cK = K, ck0 = k0, cn0 = n0, cmode = mode; \
        __syncthreads(); \
        if ((nxt_) < cend) { CV_DECODE((nxt_), src, dst, K, N, k0, n0, mode); CV_LOAD(pre, src, N, k0, n0); } \
        _Pragma("unroll") for (int j_ = 0; j_ < 4; ++j_) { \
            const int id = tid_ + 512 * j_, n = id & 255, kc = id >> 8, ng = cn0 + n; \
            int drow = ng; \
            if (cmode == 1) drow = (ng < 1024) ? (256 * (ng >> 7) + (ng & 127)) : (256 * ((ng - 1024) >> 7) + 128 + (ng & 127));     \
            if (cmode == 2 || cmode == 3) drow = 256 * (ng >> 7) + (cmode == 3 ? 128 : 0) + (ng & 127);                               \
            const LAS float* lp = Lt + (8 * kc) * 260 + n; \
            if (cmode >= 1) {     \
                u32x2 o8; o8.x = pack4_fp8_raw(lp[0] * 16.f, lp[260] * 16.f, lp[2 * 260] * 16.f, lp[3 * 260] * 16.f); o8.y = pack4_fp8_raw(lp[4 * 260] * 16.f, lp[5 * 260] * 16.f, lp[6 * 260] * 16.f, lp[7 * 260] * 16.f); \
                *(u32x2*)((unsigned char*)cdst + (size_t)drow * cK + ck0 + 8 * kc) = o8; \
            } else { \
                u32x4 o; o.x = cvt_pk_bf16(lp[0], lp[260]); o.y = cvt_pk_bf16(lp[2 * 260], lp[3 * 260]); o.z = cvt_pk_bf16(lp[4 * 260], lp[5 * 260]); o.w = cvt_pk_bf16(lp[6 * 260], lp[7 * 260]); \
                *(u32x4*)(cdst + (size_t)drow * cK + ck0 + 8 * kc) = o; \
            } } } while (0)
    if (cbeg < cend) { CV_DECODE(cbeg, srcA, dstA, KA, NA, k0A, n0A, modeA); CV_LOAD(preA, srcA, NA, k0A, n0A); }
    if (cbeg + 1 < cend) { CV_DECODE(cbeg + 1, srcB, dstB, KB, NB_, k0B, n0B, modeB); CV_LOAD(preB, srcB, NB_, k0B, n0B); }
    for (int it = cbeg; it < cend; it += 2) {
        CV_ITEM(preA, srcA, dstA, KA, NA, k0A, n0A, modeA, 0, it + 2);
        if (it + 1 < cend) CV_ITEM(preB, srcB, dstB, KB, NB_, k0B, n0B, modeB, 1, it + 3);
    }
    __syncthreads();
#undef CV_DECODE
#undef CV_LOAD
#undef CV_ITEM
}

__device__ __forceinline__ void phase_p0(const Params& p, const Ctx& cx) {
    const int lane_ = opaque_v(lane_id()), tid_ = cx.wave * 64 + lane_;
    LAS float* cact = (LAS float*)(cx.lds + 69632);
#pragma unroll 8
    for (int idx = tid_; idx < NB * DM; idx += NWAVES * 64) { const int b = idx >> 10, k = idx & 1023; const float v = p.c[idx]; cact[k * 16 + b] = v * sigmoidf_(v); }
    __syncthreads();
    {
        LAS float* pw = (LAS float*)cx.lds;
        LAS float* Bb = pw + 17 * 64 * 2;
        LAS float* Cm = Bb + 64 * 16 * 2;
        LAS float* Km = Cm + 16 * 64 * 2;
        LAS float* dv = Km + 16 * 16 * 16;
        for (int it = cx.vcu; it < 2 * SG; it += cx.G) {
            const int si = it >> 6, g = it & 63;
            if (tid_ < 64) {
                const int gi = (si * 64 + g) * 64 + tid_;
                const float dt = expf(p.ssm_log_dt[si * 64 + g]);
                const float lr = p.ssm_lam_re[gi], li = p.ssm_lam_im[gi];
                const float mag = expf(lr * dt); float sn, cs; sincosf(li * dt, &sn, &cs);
                const float ab_re = mag * cs, ab_im = mag * sn;
                const float den = lr * lr + li * li, n_re = ab_re - 1.0f;
                const float f_re = (n_re * lr + ab_im * li) / den, f_im = (ab_im * lr - n_re * li) / den;
                float pr = 1.0f, pi = 0.0f;
                for (int j = 0; j <= 16; ++j) { pw[(j * 64 + tid_) * 2] = pr; pw[(j * 64 + tid_) * 2 + 1] = pi; const float nr = pr * ab_re - pi * ab_im, ni = pr * ab_im + pi * ab_re; pr = nr; pi = ni; }
                for (int c = 0; c < 16; ++c) { const float br = p.ssm_b_re[(size_t)gi * 16 + c], bi = p.ssm_b_im[(size_t)gi * 16 + c];
                    Bb[(tid_ * 16 + c) * 2] = f_re * br - f_im * bi; Bb[(tid_ * 16 + c) * 2 + 1] = f_re * bi + f_im * br; }
            }
            for (int e = tid_; e < 1024; e += NWAVES * 64) { Cm[e * 2] = p.ssm_c_re[(size_t)(si * 64 + g) * 1024 + e]; Cm[e * 2 + 1] = p.ssm_c_im[(size_t)(si * 64 + g) * 1024 + e]; }
            if (tid_ < 16) dv[tid_] = p.ssm_d[si * DM + g * 16 + tid_];
            __syncthreads();
            {
                const int j = tid_ >> 5, co = (tid_ >> 1) & 15, ch = tid_ & 1;
                float a[8];
#pragma unroll
                for (int q = 0; q < 8; ++q) a[q] = 0.f;
                for (int pp = 0; pp < 64; ++pp) {
                    const f32x2 cc = *(const LAS f32x2*)(Cm + (co * 64 + pp) * 2), ww = *(const LAS f32x2*)(pw + (j * 64 + pp) * 2);
                    const float zr = cc[0] * ww[0] - cc[1] * ww[1], zi = cc[0] * ww[1] + cc[1] * ww[0];
                    const LAS f32x4* bp = (const LAS f32x4*)(Bb + (pp * 16 + 8 * ch) * 2);
                    const f32x4 b0 = bp[0], b1 = bp[1], b2 = bp[2], b3 = bp[3];
                    a[0] += zr * b0[0] - zi * b0[1]; a[1] += zr * b0[2] - zi * b0[3]; a[2] += zr * b1[0] - zi * b1[1]; a[3] += zr * b1[2] - zi * b1[3];
                    a[4] += zr * b2[0] - zi * b2[1]; a[5] += zr * b2[2] - zi * b2[3]; a[6] += zr * b3[0] - zi * b3[1]; a[7] += zr * b3[2] - zi * b3[3];
                }
#pragma unroll
                for (int q = 0; q < 8; ++q) Km[(j * 16 + co) * 16 + 8 * ch + q] = a[q];
            }
            __syncthreads();
            bf16_t* TH = (bf16_t*)(p.ws + WS_SSMM + (size_t)si * 20 * MiB) + (size_t)g * 256 * 384;
            bf16_t* Gm = (bf16_t*)(p.ws + WS_SSMM + (size_t)si * 20 * MiB + 12 * MiB) + (size_t)g * 256 * 256;
            for (int ch = tid_; ch < 256 * 48; ch += NWAVES * 64) {
                const int n = ch / 48, kk0 = (ch % 48) * 8, t = n >> 4, co = n & 15; float v[8];
#pragma unroll
                for (int q = 0; q < 8; ++q) { const int kk = kk0 + q;
                    if (kk < 256) { const int s_ = kk >> 4, ci = kk & 15; v[q] = (s_ <= t) ? Km[((t - s_) * 16 + co) * 16 + ci] + ((s_ == t && ci == co) ? dv[co] : 0.f) : 0.f; }
                    else { const int pp = (kk - 256) & 63, im = (kk - 256) >> 6;
                        const float cr = Cm[(co * 64 + pp) * 2], cim = Cm[(co * 64 + pp) * 2 + 1], wr_ = pw[((t + 1) * 64 + pp) * 2], wi_ = pw[((t + 1) * 64 + pp) * 2 + 1];
                        v[q] = im ? -(cr * wi_ + cim * wr_) : (cr * wr_ - cim * wi_); } }
                u32x4 o; o.x = cvt_pk_bf16(v[0], v[1]); o.y = cvt_pk_bf16(v[2], v[3]); o.z = cvt_pk_bf16(v[4], v[5]); o.w = cvt_pk_bf16(v[6], v[7]);
                *(u32x4*)(TH + (size_t)n * 384 + kk0) = o;
            }
            for (int ch = tid_; ch < 256 * 32; ch += NWAVES * 64) {
                const int n = ch >> 5, kk0 = (ch & 31) * 8; float v[8];
#pragma unroll
                for (int q = 0; q < 8; ++q) { const int kk = kk0 + q, s_ = kk >> 4, ci = kk & 15;
                    if (n < 128) { const int pp = n & 63, im = n >> 6; const float wr_ = pw[((15 - s_) * 64 + pp) * 2], wi_ = pw[((15 - s_) * 64 + pp) * 2 + 1], br = Bb[(pp * 16 + ci) * 2], bi = Bb[(pp * 16 + ci) * 2 + 1];
                        v[q] = im ? (wr_ * bi + wi_ * br) : (wr_ * br - wi_ * bi); }
                    else v[q] = 0.f; }
                u32x4 o; o.x = cvt_pk_bf16(v[0], v[1]); o.y = cvt_pk_bf16(v[2], v[3]); o.z = cvt_pk_bf16(v[4], v[5]); o.w = cvt_pk_bf16(v[6], v[7]);
                *(u32x4*)(Gm + (size_t)n * 256 + kk0) = o;
            }
            __syncthreads();
        }
    }
    float* ada = (float*)(p.ws + WS_ADA);
    float* abar = (float*)(p.ws + WS_SSMP);
    constexpr int N_ADA_IT = 4 * 384, N_SSM_IT = 2 * 64;
    constexpr int N_ITEMS = N_ADA_IT + N_SSM_IT;
    for (int it = cx.gw; it < N_ITEMS; it += cx.NGW) {
        if (it < N_ADA_IT) {
            const int l = it / 384, nb = it % 384, cq4 = lane_ & 3, ks = lane_ >> 2, col = nb * 16 + 4 * cq4;
            f32x4 acc[16];
#pragma unroll
            for (int b = 0; b < 16; ++b) acc[b] = (f32x4){0.f, 0.f, 0.f, 0.f};
            const float* W = p.w_ada + (size_t)l * DM * ADA + (size_t)(ks * 64) * ADA + col;
            const LAS float* cs_ = cact + ks * 64 * 16;
            for (int k0 = 0; k0 < 64; k0 += 8) {
                f32x4 w[8];
#pragma unroll
                for (int q = 0; q < 8; ++q) w[q] = *(const f32x4*)(W + (size_t)(k0 + q) * ADA);
#pragma unroll
                for (int q = 0; q < 8; ++q) {
                    const LAS f32x4* cp = (const LAS f32x4*)(cs_ + (k0 + q) * 16);
#pragma unroll
                    for (int b4 = 0; b4 < 4; ++b4) { const f32x4 c4 = cp[b4];
#pragma unroll
                        for (int e = 0; e < 4; ++e) acc[4 * b4 + e] += w[q] * c4[e]; }
                }
            }
#pragma unroll
            for (int b = 0; b < 16; ++b)
#pragma unroll
                for (int e = 0; e < 4; ++e) { float v = acc[b][e]; v += xor_swz<4>(v); v += xor_swz<8>(v); v += xor_swz<16>(v); acc[b][e] = half_sum(v); }
            if (lane_ < 4) { const f32x4 bias = *(const f32x4*)(p.b_ada + l * ADA + col);
#pragma unroll
                for (int b = 0; b < 16; ++b) *(f32x4*)(ada + (size_t)(l * 16 + b) * ADA + col) = acc[b] + bias; }
            continue;
        }
        int r = it - N_ADA_IT;
        if (r < N_SSM_IT) {
            const int si = r >> 6, g = r & 63, pp = lane_, gi = (si * 64 + g) * 64 + pp;
            const float dt = expf(p.ssm_log_dt[si * 64 + g]);
            const float lr = p.ssm_lam_re[gi], li = p.ssm_lam_im[gi];
            const float mag = expf(lr * dt); float sn, cs; sincosf(li * dt, &sn, &cs);
            const float ab_re = mag * cs, ab_im = mag * sn;
            const float den = lr * lr + li * li, n_re = ab_re - 1.0f;
            const float f_re = (n_re * lr + ab_im * li) / den, f_im = (ab_im * lr - n_re * li) / den;
            abar[gi * 2 + 0] = ab_re; abar[gi * 2 + 1] = ab_im;
            continue;
        }
    }
    __syncthreads();
    {
        constexpr int NCI = CI_DENSE + (CONV_IN_TAIL ? 1 : DEPTH) * NE * CI_EXP;
        constexpr int CH = 2, NCH = (NCI + CH - 1) / CH;
        unsigned* ctr = (unsigned*)(p.ws + WS_CTL) + CW_CONV + 7 * 64;
        volatile LAS unsigned* slot = (volatile LAS unsigned*)(cx.lds + MISC_OFF) + 100;
        if (tid_ == 0) *slot = __hip_atomic_fetch_add(ctr, 1u, __ATOMIC_RELAXED, __HIP_MEMORY_SCOPE_AGENT);
        __syncthreads();
        unsigned cur = *slot;
        while (cur < (unsigned)NCH) {
            unsigned nxt = 0;
            if (tid_ == 0) nxt = __hip_atomic_fetch_add(ctr, 1u, __ATOMIC_RELAXED, __HIP_MEMORY_SCOPE_AGENT);
            { const int cbeg = (int)cur * CH; int cend = cbeg + CH; if (cend > NCI) cend = NCI; conv_range(p, cx, tid_, cbeg, cend); }
            if (tid_ == 0) *slot = nxt;
            __syncthreads();
            cur = *slot;
        }
    }
}

template <int MODE>
__device__ __forceinline__ void phase_n1(const Params& p, const Ctx& cx, int l, const float* g2l) {
    const int lane_ = opaque_v(lane_id()), tid_ = cx.wave * 64 + lane_;
    const float* ada = (const float*)(p.ws + WS_ADA);
    const unsigned char* Y8 = (const unsigned char*)(p.ws + WS_R + R_Y);
    bf16_t* H = (bf16_t*)((char*)p.out + OUT_H);
    bf16_t* XB = (bf16_t*)(p.ws + WS_XB); const bf16_t* DL = (const bf16_t*)(p.ws + WS_D);
    if (MODE != 2) {
        const float* We = p.moe_w_expert + (size_t)l * DM * NE; const float* Wg = p.moe_w_group + (size_t)l * DM * 4; const float* gn = p.norm_ffn + l * DM;
        unsigned char* WR = p.ws + WS_WR; float* WRC = (float*)(p.ws + WS_WR + 16 * 147456);
        for (int it = cx.gw * 64 + lane_; it < 16 * 36 * 128; it += cx.NGW * 64) {
            const int b = it / 4608, rem = it % 4608, chunk = rem / 36, j = rem % 36, k0 = chunk * 8; float w[8];
            const float* sc2 = ada + (size_t)(l * 16 + b) * ADA + 4096;
#pragma unroll
            for (int q = 0; q < 8; ++q) { const int k = k0 + q; const float wv = (j < 32) ? We[k * NE + j] : Wg[k * 4 + (j - 32)]; w[q] = wv * gn[k] * (1.0f + sc2[k]); }
            u32x4 hi, lo;
            hi.x = cvt_pk_bf16(w[0], w[1]); hi.y = cvt_pk_bf16(w[2], w[3]); hi.z = cvt_pk_bf16(w[4], w[5]); hi.w = cvt_pk_bf16(w[6], w[7]);
            lo.x = cvt_pk_bf16(w[0] - bf_lo(hi.x), w[1] - bf_hi(hi.x)); lo.y = cvt_pk_bf16(w[2] - bf_lo(hi.y), w[3] - bf_hi(hi.y));
            lo.z = cvt_pk_bf16(w[4] - bf_lo(hi.z), w[5] - bf_hi(hi.z)); lo.w = cvt_pk_bf16(w[6] - bf_lo(hi.w), w[7] - bf_hi(hi.w));
            const unsigned off = (unsigned)(j * 2048 + ((chunk & ~15) | ((chunk ^ j) & 15)) * 16);
            *(u32x4*)(WR + (size_t)b * 147456 + off) = hi; *(u32x4*)(WR + (size_t)b * 147456 + 73728 + off) = lo;
        }
        for (int it = cx.gw; it < 16 * 36; it += cx.NGW) {
            const int b = it / 36, j = it % 36; const float* sh2 = ada + (size_t)(l * 16 + b) * ADA + 3072; float a = 0.f;
#pragma unroll
            for (int q = 0; q < 16; ++q) { const int k = lane_ + 64 * q; a += sh2[k] * ((j < 32) ? We[k * NE + j] : Wg[k * 4 + (j - 32)]); }
            a = wave_sum(a);
            if (lane_ == 0) WRC[b * 48 + j] = a + ((j < 32) ? p.moe_b_expert[l * NE + j] : p.moe_b_group[l * 4 + j - 32]);
        }
    }
    for (int rb = cx.gw; rb < NTOK / 16; rb += cx.NGW) {
        const int row0 = rb * 16, b = row0 >> 11;
        f32x4 A[2][2], Bv[2][2], G2[2][2];
#pragma unroll
        for (int j = 0; j < 2; ++j)
#pragma unroll
            for (int q = 0; q < 2; ++q) { const int col = 8 * lane_ + 512 * j + 4 * q;
                if (MODE != 2) { const f32x4 gain = *(const f32x4*)(p.norm_mix + l * DM + col); const f32x4 sc = *(const f32x4*)(ada + (size_t)(l * 16 + b) * ADA + 1024 + col);
                    A[j][q] = gain * (sc + 1.0f); Bv[j][q] = *(const f32x4*)(ada + (size_t)(l * 16 + b) * ADA + col); }
                if (MODE != 0) G2[j][q] = *(const f32x4*)(g2l + (size_t)b * ADA + col); }
        for (int r = 0; r < 16; r += 2) {
            f32x4 v[2][2][2]; float ss[2];
#pragma unroll
            for (int rr = 0; rr < 2; ++rr) {
                const size_t row = (size_t)(row0 + r + rr); ss[rr] = 0.f;
#pragma unroll
                for (int j = 0; j < 2; ++j) { const int col = 8 * lane_ + 512 * j;
                    if (MODE == 0) { v[rr][j][0] = *(const f32x4*)(p.x + row * DM + col); v[rr][j][1] = *(const f32x4*)(p.x + row * DM + col + 4); }
                    else {
                        const u32x4 xb = *(const u32x4*)(XB + row * DM + col), dl = *(const u32x4*)(DL + row * DM + col);
                        const u32x2 y0 = *(const u32x2*)(Y8 + row * DM + col), y1 = *(const u32x2*)(Y8 + ((size_t)NTOK + row) * DM + col);
                        const f32x4 ys0 = unpack4_fp8(y0.x) + unpack4_fp8(y1.x), ys1 = unpack4_fp8(y0.y) + unpack4_fp8(y1.y);
                        f32x4 x0, x1;
                        x0[0] = bf_lo(xb.x) + bf_lo(dl.x); x0[1] = bf_hi(xb.x) + bf_hi(dl.x); x0[2] = bf_lo(xb.y) + bf_lo(dl.y); x0[3] = bf_hi(xb.y) + bf_hi(dl.y);
                        x1[0] = bf_lo(xb.z) + bf_lo(dl.z); x1[1] = bf_hi(xb.z) + bf_hi(dl.z); x1[2] = bf_lo(xb.w) + bf_lo(dl.w); x1[3] = bf_hi(xb.w) + bf_hi(dl.w);
                        v[rr][j][0] = x0 + G2[j][0] * ys0; v[rr][j][1] = x1 + G2[j][1] * ys1; }
                    const f32x4 a0 = v[rr][j][0], a1 = v[rr][j][1];
                    if (MODE == 2) { *(f32x4*)(p.out + row * DM + col) = a0; *(f32x4*)(p.out + row * DM + col + 4) = a1; }
                    else { u32x4 w; w.x = cvt_pk_bf16(a0[0], a0[1]); w.y = cvt_pk_bf16(a0[2], a0[3]); w.z = cvt_pk_bf16(a1[0], a1[1]); w.w = cvt_pk_bf16(a1[2], a1[3]); *(u32x4*)(XB + row * DM + col) = w; }
                    ss[rr] += ((a0[0] * a0[0] + a0[1] * a0[1]) + (a0[2] * a0[2] + a0[3] * a0[3])) + ((a1[0] * a1[0] + a1[1] * a1[1]) + (a1[2] * a1[2] + a1[3] * a1[3])); }
            }
            if (MODE != 2) {
#pragma unroll
                for (int rr = 0; rr < 2; ++rr) ss[rr] = wave_sum(ss[rr]);
#pragma unroll
                for (int rr = 0; rr < 2; ++rr) {
                    const size_t row = (size_t)(row0 + r + rr);
                    const float rstd = rsqrtf(ss[rr] * (1.0f / DM) + RMS_EPS);
#pragma unroll
                    for (int j = 0; j < 2; ++j) { const int col = 8 * lane_ + 512 * j; const f32x4 h0 = v[rr][j][0] * rstd * A[j][0] + Bv[j][0], h1 = v[rr][j][1] * rstd * A[j][1] + Bv[j][1];
                        if (l & 1) { u32x2 w8; w8.x = pack4_fp8_raw(h0[0], h0[1], h0[2], h0[3]); w8.y = pack4_fp8_raw(h1[0], h1[1], h1[2], h1[3]); *(u32x2*)((unsigned char*)H + row * DM + col) = w8; }
                        else { u32x4 w; w.x = cvt_pk_bf16(h0[0], h0[1]); w.y = cvt_pk_bf16(h0[2], h0[3]); w.z = cvt_pk_bf16(h1[0], h1[1]); w.w = cvt_pk_bf16(h1[2], h1[3]); *(u32x4*)(H + row * DM + col) = w; } }
                }
            }
        }
    }
}

typedef float f32x4v __attribute__((ext_vector_type(4)));
__device__ __forceinline__ unsigned n2_wslot(int j, int chunk) { return (unsigned)(j * 2048 + ((chunk & ~15) | ((chunk ^ j) & 15)) * 16); }
__device__ __forceinline__ void phase_n2(const Params& p, const Ctx& cx, int l, int cl) {
    const int lane_ = opaque_v(lane_id()), tid_ = cx.wave * 64 + lane_;
    const float* ada = (const float*)(p.ws + WS_ADA);
    unsigned char* H8 = (unsigned char*)p.out + OUT_H;
    const bf16_t* XB = (const bf16_t*)(p.ws + WS_XB); const bf16_t* DL = (const bf16_t*)(p.ws + WS_D);
    LAS unsigned char* Whi = cx.lds;
    LAS unsigned char* Wlo = cx.lds + 73728;
    LAS float* LG = (LAS float*)cx.lds;
    LAS int* cnt = (LAS int*)(cx.lds + N2_TAB);
    LAS int* basev = cnt + 32;
    LAS int* ri_e = cnt + 64;
    LAS int* ri_s = cnt + 64 + 256;
    LAS float* ri_g = (LAS float*)(cnt + 64 + 512);
    LAS float* rs = (LAS float*)(cnt + 64 + 768);
    LAS float* cb = rs + 128;
    unsigned* gcnt = (unsigned*)(p.ws + WS_CTL) + CW_GCNT + cl * 32 * 64;
    u32x2* list = (u32x2*)(p.ws + WS_LIST);
    const float* We = p.moe_w_expert + (size_t)l * DM * NE; const float* Wg = p.moe_w_group + (size_t)l * DM * 4;
    for (int rb = cx.vcu; rb < NTOK / 128; rb += cx.G) {
        const int wrow0 = rb * 128 + cx.wave * 16, b = wrow0 >> 11;
        const float* sc2 = ada + (size_t)(l * 16 + b) * ADA + 4096; const float* sh2 = ada + (size_t)(l * 16 + b) * ADA + 3072; const float* gn = p.norm_ffn + l * DM;
        if (tid_ < 32) cnt[tid_] = 0;
        const int c16 = lane_ & 15, fq = lane_ >> 4;
        const bf16_t* xr = XB + (size_t)(wrow0 + c16) * DM + 16 * fq; const bf16_t* dr = DL + (size_t)(wrow0 + c16) * DM + 16 * fq;
        u32x4 xq[16][2], dq[16][2], x2p[16][2];
#define N2_LD(S_) do { xq[S_][0] = *(const u32x4*)(xr + 64 * (S_)); xq[S_][1] = *(const u32x4*)(xr + 64 * (S_) + 8); dq[S_][0] = *(const u32x4*)(dr + 64 * (S_)); dq[S_][1] = *(const u32x4*)(dr + 64 * (S_) + 8); } while (0)
        N2_LD(0); N2_LD(1);
        {
            const u32x4* src = (const u32x4*)(p.ws + WS_WR + (size_t)b * 147456);
#pragma unroll 6
            for (int i = tid_; i < 147456 / 16; i += NWAVES * 64) ((LAS u32x4*)cx.lds)[i] = src[i];
            if (tid_ < 36) cb[tid_] = ((const float*)(p.ws + WS_WR + 16 * 147456))[b * 48 + tid_];
            LAS float* AB = (LAS float*)(cx.lds + N2_AB);
#pragma unroll
            for (int q = 0; q < 2; ++q) { const int k = tid_ + 512 * q; AB[k] = gn[k] * (1.0f + sc2[k]); AB[1024 + k] = sh2[k]; }
        }
        __syncthreads();
        f32x4v acc[3];
#pragma unroll
        for (int t = 0; t < 3; ++t) acc[t] = (f32x4v){0.f, 0.f, 0.f, 0.f};
        float ssq = 0.f;
        {
            const int j2 = (32 + c16) < 36 ? (32 + c16) : 35;
            int wb[3];
#pragma unroll
            for (int t = 0; t < 3; ++t) { const int j = (t == 2) ? j2 : 16 * t + c16; wb[t] = j * 2048 + 16 * (((2 * fq) ^ j) & 15); }
#pragma unroll
            for (int S = 0; S < 16; ++S) {
                __builtin_amdgcn_sched_barrier(0);
                if (S + 2 < 16) N2_LD(S + 2);
                __builtin_amdgcn_sched_barrier(0);
#pragma unroll
                for (int u = 0; u < 2; ++u) {
                    bf16x8 wh[3], wl[3];
#pragma unroll
                    for (int t = 0; t < 3; ++t) { const int a = opaque_v(wb[t]) ^ (16 * (u | 8 * (S & 1)));
                        wh[t] = *(const LAS bf16x8*)(Whi + a + 256 * (S >> 1)); wl[t] = *(const LAS bf16x8*)(Whi + (a + 73728) + 256 * (S >> 1)); }
                    const u32x4 xw = xq[S][u], dw = dq[S][u];
                    const bf16x8 xa = __builtin_bit_cast(bf16x8, xw), da = __builtin_bit_cast(bf16x8, dw);
#pragma unroll
                    for (int t = 0; t < 3; ++t) acc[t] = __builtin_amdgcn_mfma_f32_16x16x32_bf16(xa, wh[t], acc[t], 0, 0, 0);
#pragma unroll
                    for (int t = 0; t < 3; ++t) acc[t] = __builtin_amdgcn_mfma_f32_16x16x32_bf16(da, wh[t], acc[t], 0, 0, 0);
#pragma unroll
                    for (int t = 0; t < 3; ++t) acc[t] = __builtin_amdgcn_mfma_f32_16x16x32_bf16(xa, wl[t], acc[t], 0, 0, 0);
#pragma unroll
                    for (int t = 0; t < 3; ++t) acc[t] = __builtin_amdgcn_mfma_f32_16x16x32_bf16(da, wl[t], acc[t], 0, 0, 0);
                    f32x4 v0, v1;
                    v0[0] = bf_lo(xw.x) + bf_lo(dw.x); v0[1] = bf_hi(xw.x) + bf_hi(dw.x); v0[2] = bf_lo(xw.y) + bf_lo(dw.y); v0[3] = bf_hi(xw.y) + bf_hi(dw.y);
                    v1[0] = bf_lo(xw.z) + bf_lo(dw.z); v1[1] = bf_hi(xw.z) + bf_hi(dw.z); v1[2] = bf_lo(xw.w) + bf_lo(dw.w); v1[3] = bf_hi(xw.w) + bf_hi(dw.w);
                    ssq += ((v0[0] * v0[0] + v0[1] * v0[1]) + (v0[2] * v0[2] + v0[3] * v0[3])) + ((v1[0] * v1[0] + v1[1] * v1[1]) + (v1[2] * v1[2] + v1[3] * v1[3]));
                    u32x4 pk; pk.x = cvt_pk_bf16(v0[0], v0[1]); pk.y = cvt_pk_bf16(v0[2], v0[3]); pk.z = cvt_pk_bf16(v1[0], v1[1]); pk.w = cvt_pk_bf16(v1[2], v1[3]);
                    x2p[S][u] = pk;
                }
            }
        }
#undef N2_LD
        {
            ssq += xor_swz<16>(ssq); ssq = half_sum(ssq);
            const float rstd = rsqrtf(ssq * (1.0f / DM) + RMS_EPS);
            const int lane3 = opaque_v(lane_id()), c16c = lane3 & 15, fqc = lane3 >> 4;
            if (fqc == 0) rs[cx.wave * 16 + c16c] = rstd;
            const LAS float* AB = (const LAS float*)(cx.lds + opaque_v(N2_AB + 64 * fqc));
            unsigned char* hrow = H8 + (size_t)(wrow0 + c16c) * DM + 16 * fqc;
#pragma unroll
            for (int S = 0; S < 16; ++S) {
                __builtin_amdgcn_sched_barrier(0);
                u32x4 w8;
#pragma unroll
                for (int u = 0; u < 2; ++u) {
                    const int k0 = 64 * S + 8 * u;
                    const f32x4 a0 = *(const LAS f32x4*)(AB + k0), a1 = *(const LAS f32x4*)(AB + k0 + 4), b0 = *(const LAS f32x4*)(AB + 1024 + k0), b1 = *(const LAS f32x4*)(AB + 1024 + k0 + 4);
                    const u32x4 pk = x2p[S][u];
                    const float h0 = bf_lo(pk.x) * (rstd * a0[0]) + b0[0], h1 = bf_hi(pk.x) * (rstd * a0[1]) + b0[1], h2_ = bf_lo(pk.y) * (rstd * a0[2]) + b0[2], h3 = bf_hi(pk.y) * (rstd * a0[3]) + b0[3];
                    const float h4 = bf_lo(pk.z) * (rstd * a1[0]) + b1[0], h5 = bf_hi(pk.z) * (rstd * a1[1]) + b1[1], h6 = bf_lo(pk.w) * (rstd * a1[2]) + b1[2], h7 = bf_hi(pk.w) * (rstd * a1[3]) + b1[3];
                    const unsigned lo_ = pack4_fp8_raw(h0, h1, h2_, h3), hi_ = pack4_fp8_raw(h4, h5, h6, h7);
                    if (u == 0) { w8.x = lo_; w8.y = hi_; } else { w8.z = lo_; w8.w = hi_; }
                }
                *(u32x4*)(hrow + 64 * S) = w8;
            }
        }
        __syncthreads();
        const int lane2 = opaque_v(lane_id()), tid2 = cx.wave * 64 + lane2, c16b = lane2 & 15, fqb = lane2 >> 4;
        {
            LAS float* lgw = LG + cx.wave * (16 * 48);
#pragma unroll
            for (int t = 0; t < 3; ++t)
#pragma unroll
                for (int i = 0; i < 4; ++i) { const int rho = 4 * fqb + i, col = 16 * t + c16b; if (col < 36) lgw[rho * 48 + col] = acc[t][i] * rs[cx.wave * 16 + rho] + cb[col]; }
            asm volatile("s_waitcnt lgkmcnt(0)" ::: "memory");
            if (lane2 < 16) {
                const LAS float* lr = lgw + lane2 * 48;
                int gi = 0; float gm = lr[32];
#pragma unroll
                for (int i = 1; i < 4; ++i) { const float v = lr[32 + i]; if (v > gm) { gm = v; gi = i; } }
                float gden = 0.f;
#pragma unroll
                for (int i = 0; i < 4; ++i) gden += __expf(lr[32 + i] - gm);
                const float gwt = 1.0f / gden;
                float l1 = -3.0e38f, l2 = -3.0e38f; int i1 = 0, i2 = 0;
#pragma unroll
                for (int i = 0; i < 8; ++i) { const float ev = lr[gi * 8 + i];
                    if (ev > l1) { l2 = l1; i2 = i1; l1 = ev; i1 = i; } else if (ev > l2) { l2 = ev; i2 = i; } }
                const float tt = __expf(l2 - l1), p1 = 1.0f / (1.0f + tt), p2 = tt * p1;
                const int rloc = cx.wave * 16 + lane2, e1 = gi * 8 + i1, e2 = gi * 8 + i2;
                const int s1 = __hip_atomic_fetch_add(cnt + e1, 1, __ATOMIC_RELAXED, __HIP_MEMORY_SCOPE_WORKGROUP);
                const int s2 = __hip_atomic_fetch_add(cnt + e2, 1, __ATOMIC_RELAXED, __HIP_MEMORY_SCOPE_WORKGROUP);
                ri_e[rloc * 2] = e1; ri_e[rloc * 2 + 1] = e2; ri_s[rloc * 2] = s1; ri_s[rloc * 2 + 1] = s2; ri_g[rloc * 2] = gwt * p1; ri_g[rloc * 2 + 1] = gwt * p2;
            }
        }
        __syncthreads();
        if (tid2 < 32) basev[tid2] = (int)__hip_atomic_fetch_add(gcnt + tid2 * 64, (unsigned)cnt[tid2], __ATOMIC_RELAXED, __HIP_MEMORY_SCOPE_AGENT);
        __syncthreads();
        if (tid2 < 256) { const int e = ri_e[tid2], slot = basev[e] + ri_s[tid2]; const unsigned tok = (unsigned)(rb * 128 + (tid2 >> 1));
            u32x2 ent; ent.x = tok * 2u + (unsigned)(tid2 & 1); ent.y = __float_as_uint(ri_g[tid2]); list[(size_t)e * NTOK + slot] = ent; }
        __syncthreads();
    }
}

template <int NCT, bool WITH_GATE>
__device__ __forceinline__ int moe_setup(const Params& p, const Ctx& cx, int l) {
    const int lane_ = opaque_v(lane_id()), tid_ = cx.wave * 64 + lane_;
    LAS int* utab = (LAS int*)(cx.lds + MOE_TAB);
    LAS int* nun = utab + MAXU * 8;
    LAS int* ecnt = (LAS int*)(cx.lds + 65536);
    unsigned* gcnt = (unsigned*)(p.ws + WS_CTL) + CW_GCNT + l * 32 * 64;
    const u32x2* list = (const u32x2*)(p.ws + WS_LIST);
    LAS int* toff = ecnt + 32;
    if (tid_ < 32) ecnt[tid_] = (int)__hip_atomic_load(gcnt + tid_ * 64, __ATOMIC_RELAXED, __HIP_MEMORY_SCOPE_AGENT);
    __syncthreads();
    if (tid_ < 32) {
        int acc = 0;
        for (int e = 0; e < 32; ++e) { const int ntl = (ecnt[e] + 255) >> 8; acc += (e < tid_) ? ntl : 0; }
        toff[tid_] = acc;
        if (tid_ == 31) toff[32] = acc + ((ecnt[31] + 255) >> 8);
    }
    __syncthreads();
    if (tid_ < MAXU) {
        const int T = toff[32], i = tid_;
        const int L = i * cx.G + cx.vcu, t = L / NCT, pn = L % NCT;
        int valid = (t < T) ? 1 : 0, e = 0;
        for (int q = 0; q < 32; ++q) e = (toff[q] <= t) ? q : e;
        const int tie = t - toff[e]; int rows = ecnt[e] - tie * 256; rows = rows > 256 ? 256 : rows;
        if (valid) { utab[i * 8 + 0] = t; utab[i * 8 + 1] = pn; utab[i * 8 + 2] = e; utab[i * 8 + 3] = rows; utab[i * 8 + 4] = tie; }
        const unsigned long long m = __ballot(valid != 0);
        if (tid_ == 0) { *nun = __popcll(m); nun[1] = T; }
    }
    __syncthreads();
    const int nu = *nun;
    for (int i = 0; i < nu; ++i) {
        const int e = utab[i * 8 + 2], rows = utab[i * 8 + 3], tie = utab[i * 8 + 4];
        if (tid_ < 256) {
            const bool valid = tid_ < rows;
            u32x2 ent; ent.x = 0xffffffffu; ent.y = 0u;
            if (valid) ent = list[(size_t)e * NTOK + tie * 256 + tid_];
            if (WITH_GATE) ((LAS u32x2*)(cx.lds + MOE_TAB + 256))[i * 256 + tid_] = ent;
            else ((LAS unsigned*)(cx.lds + MOE_TAB + 256))[i * 256 + tid_] = valid ? (ent.x >> 1) : 0u;
        }
    }
    if (WITH_GATE) {
        LAS unsigned* idt = (LAS unsigned*)(cx.lds + MOE_TAB + 256 + MAXU * 256 * 8);
        for (int i = 0; i < nu; ++i) if (tid_ < 256) idt[i * 256 + tid_] = (unsigned)(utab[i * 8 + 0] * 256 + tid_);
    }
    __syncthreads();
    return nu;
}

typedef float f32x16 __attribute__((ext_vector_type(16)));
__device__ __forceinline__ float half_max(float v) { const auto r = __builtin_amdgcn_permlane32_swap(__float_as_uint(v), __float_as_uint(v), false, false); return fmaxf(__uint_as_float(r[0]), __uint_as_float(r[1])); }
__device__ __forceinline__ float ssq8(const u32x4 w) { const float a0 = bf_lo(w.x), a1 = bf_hi(w.x), a2 = bf_lo(w.y), a3 = bf_hi(w.y), a4 = bf_lo(w.z), a5 = bf_hi(w.z), a6 = bf_lo(w.w), a7 = bf_hi(w.w);
    return (a0 * a0 + a1 * a1) + (a2 * a2 + a3 * a3) + (a4 * a4 + a5 * a5) + (a6 * a6 + a7 * a7); }
__device__ __forceinline__ void phase_attn(const Params& p, const Ctx& cx, int li, unsigned char* Odst) {
    const int lane_ = opaque_v(lane_id()), tid_ = cx.wave * 64 + lane_, r = lane_ & 31, h = lane_ >> 5;
    bf16_t* Q = (bf16_t*)(p.ws + WS_R + R_Q);
    const bf16_t* Kb = (const bf16_t*)(p.ws + WS_R + R_K);
    const bf16_t* Vt = (const bf16_t*)(p.ws + WS_R + R_VT);
    constexpr float LOG2E = 1.4426950408889634f;
    constexpr int ABUF = 49152, AKS = 0, AVS = 24576, AGL = 2 * ABUF;
    LAS float* gl = (LAS float*)(cx.lds + AGL);
    if (lane_ < HD) gl[lane_] = p.attn_q_gain[li * HD + lane_] * p.attn_k_gain[li * HD + lane_];
    const int qtl = cx.wave >> 2, hl = cx.wave & 3;
    const int NU = NB * NKVH * (SEQ / 64);
    u32x4 kpre[3], vpre[3], qpre[4];
#define ATT_PREFETCH(u_) do { const int b_ = (u_) >> 7, kvh_ = ((u_) >> 5) & 3, kb_ = ((u_) & 31) * 64 - 128; \
        { const bf16_t* qp_ = Q + ((size_t)(b_ * SEQ + kb_ + 128 + 32 * qtl + r)) * 1024 + (kvh_ * 4 + hl) * 64 + 8 * h; _Pragma("unroll") for (int s_ = 0; s_ < 4; ++s_) qpre[s_] = *(const u32x4*)(qp_ + 16 * s_); } \
        _Pragma("unroll") for (int j_ = 0; j_ < 3; ++j_) { const int idx = tid_ + 512 * j_; \
            { const int row = idx >> 3, c = idx & 7; int key = kb_ + row; key = key < 0 ? 0 : key; kpre[j_] = *(const u32x4*)(Kb + ((size_t)(b_ * SEQ + key)) * 256 + kvh_ * 64 + 8 * c); } \
            { const int d = idx / 24, ch = idx % 24; int key0 = kb_ + 32 * (ch >> 2); key0 = key0 < 0 ? 0 : key0; vpre[j_] = *(const u32x4*)(Vt + ((size_t)((b_ * 4 + kvh_) * 64 + d)) * 2048 + key0 + 8 * (ch & 3)); } } } while (0)
#define ATT_COMMIT(buf_) do { LAS unsigned char* kb2 = cx.lds + (buf_) * ABUF + AKS; LAS unsigned char* vb2 = cx.lds + (buf_) * ABUF + AVS; \
        _Pragma("unroll") for (int j_ = 0; j_ < 3; ++j_) { const int idx = tid_ + 512 * j_; \
            { const int row = idx >> 3, c = idx & 7; float ss = ssq8(kpre[j_]); ss += xor_swz<1>(ss); ss += xor_swz<2>(ss); ss += xor_swz<4>(ss); const float rk = rsqrtf(ss * (1.0f / HD) + RMS_EPS); u32x4 o; \
              o.x = cvt_pk_bf16(bf_lo(kpre[j_].x) * rk, bf_hi(kpre[j_].x) * rk); o.y = cvt_pk_bf16(bf_lo(kpre[j_].y) * rk, bf_hi(kpre[j_].y) * rk); o.z = cvt_pk_bf16(bf_lo(kpre[j_].z) * rk, bf_hi(kpre[j_].z) * rk); o.w = cvt_pk_bf16(bf_lo(kpre[j_].w) * rk, bf_hi(kpre[j_].w) * rk); \
              *(LAS u32x4*)(kb2 + row * 128 + ((c ^ ((row >> 1) & 7)) << 4)) = o; } \
            { const int d = idx / 24, ch = idx % 24; *(LAS u32x4*)(vb2 + d * 384 + ((ch ^ ((d >> 1) & 7)) << 4)) = vpre[j_]; } } } while (0)
    int u = cx.vcu, buf = 0;
    if (u < NU) { ATT_PREFETCH(u); ATT_COMMIT(0); }
    __syncthreads();
    for (; u < NU; u += cx.G) {
        const int b = u >> 7, kvh = (u >> 5) & 3, q0 = (u & 31) * 64 + 32 * qtl, hq = kvh * 4 + hl, kpos0 = q0 - 128;
        const int kt0 = q0 >= 128 ? 0 : 4 - (q0 >> 5);
        const bool has_next = (u + cx.G) < NU;
        u32x4 qw[4];
#pragma unroll
        for (int s_ = 0; s_ < 4; ++s_) qw[s_] = qpre[s_];
        if (has_next) ATT_PREFETCH(u + cx.G);
        const LAS unsigned char* ks = cx.lds + buf * ABUF + AKS; const LAS unsigned char* vs = cx.lds + buf * ABUF + AVS;
        bf16x8 bq[4];
        {
            float ssq = 0.f;
#pragma unroll
            for (int s_ = 0; s_ < 4; ++s_) ssq += ssq8(qw[s_]);
            ssq = half_sum(ssq);
            const float rq = rsqrtf(ssq * (1.0f / HD) + RMS_EPS) * (0.125f * LOG2E);
            f32x4 gqk[4][2];
#pragma unroll
            for (int s_ = 0; s_ < 4; ++s_) { gqk[s_][0] = *(const LAS f32x4*)(gl + 16 * s_ + 8 * h); gqk[s_][1] = *(const LAS f32x4*)(gl + 16 * s_ + 8 * h + 4); }
#pragma unroll
            for (int s_ = 0; s_ < 4; ++s_) { u32x4 o;
                o.x = cvt_pk_bf16(bf_lo(qw[s_].x) * rq * gqk[s_][0][0], bf_hi(qw[s_].x) * rq * gqk[s_][0][1]); o.y = cvt_pk_bf16(bf_lo(qw[s_].y) * rq * gqk[s_][0][2], bf_hi(qw[s_].y) * rq * gqk[s_][0][3]);
                o.z = cvt_pk_bf16(bf_lo(qw[s_].z) * rq * gqk[s_][1][0], bf_hi(qw[s_].z) * rq * gqk[s_][1][1]); o.w = cvt_pk_bf16(bf_lo(qw[s_].w) * rq * gqk[s_][1][2], bf_hi(qw[s_].w) * rq * gqk[s_][1][3]);
                bq[s_] = __builtin_bit_cast(bf16x8, o); }
        }
        f32x16 st[5];
#pragma unroll
        for (int kt = 0; kt < 5; ++kt) {
            const int row = 32 * (qtl + kt) + r;
            f32x16 acc;
#pragma unroll
            for (int e = 0; e < 16; ++e) acc[e] = 0.f;
#pragma unroll
            for (int s_ = 0; s_ < 4; ++s_) { const bf16x8 kf = *(const LAS bf16x8*)(ks + row * 128 + (((2 * s_ + h) ^ ((row >> 1) & 7)) << 4));
                acc = __builtin_amdgcn_mfma_f32_32x32x16_bf16(kf, bq[s_], acc, 0, 0, 0); }
#pragma unroll
            for (int e = 0; e < 16; ++e) {
                const int row0 = (e & 3) + 8 * (e >> 2);
                float v = acc[e];
                if (kt == 0) v = (row0 + 4 * h >= r + 1) ? v : -INFINITY;
                if (kt == 4) v = (row0 + 4 * h <= r) ? v : -INFINITY;
                if (kt < 4) v = (kt >= kt0) ? v : -INFINITY;
                acc[e] = v;
            }
            st[kt] = acc;
        }
        const float sink2 = p.attn_sinks[li * NQH + hq] * LOG2E;
        float m = sink2;
#pragma unroll
        for (int kt = 0; kt < 5; ++kt)
#pragma unroll
            for (int e = 0; e < 16; ++e) m = fmaxf(m, st[kt][e]);
        m = half_max(m);
        float lsum = 0.f;
        f32x16 o0, o1;
#pragma unroll
        for (int e = 0; e < 16; ++e) { o0[e] = 0.f; o1[e] = 0.f; }
#pragma unroll
        for (int kt = 0; kt < 5; ++kt) {
#pragma unroll
            for (int e = 0; e < 16; ++e) { const float pv = __builtin_amdgcn_exp2f(st[kt][e] - m); st[kt][e] = pv; lsum += pv; }
#pragma unroll
            for (int s_ = 0; s_ < 2; ++s_) {
                u32x4 pw;
                pw.x = cvt_pk_bf16(st[kt][8 * s_ + 0], st[kt][8 * s_ + 1]); pw.y = cvt_pk_bf16(st[kt][8 * s_ + 2], st[kt][8 * s_ + 3]);
                pw.z = cvt_pk_bf16(st[kt][8 * s_ + 4], st[kt][8 * s_ + 5]); pw.w = cvt_pk_bf16(st[kt][8 * s_ + 6], st[kt][8 * s_ + 7]);
                const int ch = 4 * (qtl + kt) + 2 * h + s_;
                const bf16x8 av0 = *(const LAS bf16x8*)(vs + r * 384 + ((ch ^ ((r >> 1) & 7)) << 4));
                const bf16x8 av1 = *(const LAS bf16x8*)(vs + (32 + r) * 384 + ((ch ^ (((32 + r) >> 1) & 7)) << 4));
                o0 = __builtin_amdgcn_mfma_f32_32x32x16_bf16(av0, __builtin_bit_cast(bf16x8, pw), o0, 0, 0, 0);
                o1 = __builtin_amdgcn_mfma_f32_32x32x16_bf16(av1, __builtin_bit_cast(bf16x8, pw), o1, 0, 0, 0);
            }
        }
        lsum = half_sum(lsum) + __builtin_amdgcn_exp2f(sink2 - m);
        const float inv = 1.0f / lsum;
        unsigned char* op = Odst + ((size_t)(b * SEQ + q0 + r)) * 1024 + hq * 64 + 4 * h;
        const float inv16 = inv * 16.f;
#pragma unroll
        for (int g4 = 0; g4 < 4; ++g4) {
            *(unsigned*)(op + 8 * g4) = pack4_fp8_raw(o0[4 * g4 + 0] * inv16, o0[4 * g4 + 1] * inv16, o0[4 * g4 + 2] * inv16, o0[4 * g4 + 3] * inv16);
            *(unsigned*)(op + 32 + 8 * g4) = pack4_fp8_raw(o1[4 * g4 + 0] * inv16, o1[4 * g4 + 1] * inv16, o1[4 * g4 + 2] * inv16, o1[4 * g4 + 3] * inv16);
        }
        if (has_next) ATT_COMMIT(buf ^ 1);
        __syncthreads();
        buf ^= 1;
    }
#undef ATT_PREFETCH
#undef ATT_COMMIT
}

__device__ __forceinline__ void phase_ssm_scan(const Params& p, const Ctx& cx, int si) {
    const int lane_ = opaque_v(lane_id()), tid_ = cx.wave * 64 + lane_;
    const float* abar = (const float*)(p.ws + WS_SSMP);
    const bf16_t* Wst = (const bf16_t*)(p.ws + WS_R + R_W);
    bf16_t* US = (bf16_t*)(p.ws + WS_R + R_US);
    for (int it = cx.gw; it < SG * NB; it += cx.NGW) {
        const int g = it >> 4, b = it & 15, gi = (si * 64 + g) * 64 + lane_;
        float ar = abar[gi * 2], ai = abar[gi * 2 + 1];
#pragma unroll
        for (int q = 0; q < 4; ++q) { const float nr = ar * ar - ai * ai, ni = 2.0f * ar * ai; ar = nr; ai = ni; }
        const size_t row0 = (size_t)g * 2048 + b * 128;
        float sr = 0.f, si_ = 0.f;
#pragma unroll 8
        for (int k = 0; k < 128; ++k) {
            const float wr_ = __uint_as_float((unsigned)Wst[(row0 + k) * 128 + lane_] << 16), wi_ = __uint_as_float((unsigned)Wst[(row0 + k) * 128 + 64 + lane_] << 16);
            bf16_t* up = US + (row0 + k) * 384 + 256 + lane_;
            up[0] = (bf16_t)(cvt_pk_bf16(sr, 0.f) & 0xffffu); up[64] = (bf16_t)(cvt_pk_bf16(si_, 0.f) & 0xffffu);
            const float nr = ar * sr - ai * si_ + wr_, ni = ar * si_ + ai * sr + wi_; sr = nr; si_ = ni;
        }
    }
}

__device__ __forceinline__ void moe_tail_convert(const Params& p, const Ctx& cx, int next_layer, int total_units, int lo, int hi) {
    const int rounds = (total_units + cx.G - 1) / cx.G; int n_late = total_units - (rounds - 1) * cx.G; if (n_late >= cx.G) n_late = 0;
    if (cx.vcu < n_late) return;
    const int rank = cx.vcu - n_late, cnt = cx.G - n_late, nit = hi - lo, q = (nit + cnt - 1) / cnt; int cb = rank * q, ce = cb + q; if (cb > nit) cb = nit; if (ce > nit) ce = nit;
    const int lane2 = opaque_v(lane_id()), ibase = CI_DENSE + next_layer * NE * CI_EXP + lo;
    conv_range(p, cx, cx.wave * 64 + lane2, ibase + cb, ibase + ce);
}

__global__ void __launch_bounds__(NWAVES * 64, 2) fwd(Params p_unused) {
    extern __shared__ __attribute__((aligned(16))) unsigned char lds_raw[];
    Ctx cx;
    cx.lds = (LAS unsigned char*)lds_raw;
    const int tid0 = threadIdx.x; cx.wave = __builtin_amdgcn_readfirstlane(tid0 >> 6);
    cx.G = gridDim.x; { const int bx = blockIdx.x; cx.vcu = (cx.G % 8 == 0) ? (bx % 8) * (cx.G / 8) + bx / 8 : bx; }
    cx.gw = cx.vcu * NWAVES + cx.wave; cx.NGW = cx.G * NWAVES;
    unsigned* ctl; { const Params p = load_params(); ctl = (unsigned*)(p.ws + WS_CTL); }
    volatile LAS unsigned* MISC = (volatile LAS unsigned*)(cx.lds + MISC_OFF);
    for (int u = tid0; u < (LDS_BYTES - MISC_OFF) / 4; u += NWAVES * 64) ((LAS unsigned*)(cx.lds + MISC_OFF))[u] = 0u;
    __syncthreads();
    XcdBarrier bar = xcd_barrier_post((gu32*)ctl + CW_BAR, MISC + 8);
#define GRID_BAR() xcd_barrier<false>(bar, cx.wave)

    { const Params p = load_params(); phase_p0(p, cx); __syncthreads(); }
    xcd_barrier<true>(bar, cx.wave);

    for (int l = 0; l < DEPTH; ++l) {
        {
            const Params p = load_params();
            const float* g2l = (const float*)(p.ws + WS_ADA) + (size_t)(l - 1) * 16 * ADA + 5120;
            if (l == 0) phase_n1<0>(p, cx, 0, g2l); else phase_n1<1>(p, cx, l, g2l);
        }
        GRID_BAR();
        const int li = l >> 1;
        if ((l & 1) == 0) {
            {
                const Params p = load_params(); const bf16_t* H = (const bf16_t*)((const char*)p.out + OUT_H);
                pg8::DenseOrder S; S.init(NTOK, QKVD, DM, DM, cx.G, (int)blockIdx.x, H, (const bf16_t*)(p.ws + WS_WATT + (size_t)li * 5 * MiB));
                EpiQKV E{(bf16_t*)(p.ws + WS_R + R_Q), (bf16_t*)(p.ws + WS_R + R_K), (bf16_t*)(p.ws + WS_R + R_VT)};
                pg8::gemm_phase<EpiQKV, pg8::DenseOrder, false, true>(cx.lds, cx.wave, DM, DM, S, E, nullptr);
            }
            GRID_BAR();
            { const Params p = load_params(); phase_attn(p, cx, li, p.ws + WS_R + R_O8); }
            GRID_BAR();
            {
                const Params p = load_params();
                const float* gl = (const float*)(p.ws + WS_ADA) + (size_t)l * 16 * ADA + 2048;
                pg8::DenseOrder S; S.init(NTOK, DM, DM / 2, DM / 2, cx.G, (int)blockIdx.x, (const bf16_t*)(p.ws + WS_R + R_O8), (const bf16_t*)(p.ws + WS_WATT + (size_t)li * 5 * MiB + 3 * MiB));
                S.via_table = true;
                {
                    const int lane2 = opaque_v(lane_id()), tid2 = cx.wave * 64 + lane2; LAS unsigned* tab = (LAS unsigned*)(cx.lds + MOE_TAB + 256);
                    pg8::Unit uu; for (int i = 0; i < MAXU && S.next(i, uu); ++i) if (tid2 < 256) tab[i * 256 + tid2] = (unsigned)(uu.pm * 256 + tid2);
                    __syncthreads();
                }
                EpiDelta E{(bf16_t*)(p.ws + WS_D), gl};
                pg8::gemm_phase<EpiDelta, pg8::DenseOrder, true, true, true>(cx.lds, cx.wave, DM / 2, DM / 2, S, E, (volatile LAS const unsigned*)(cx.lds + MOE_TAB + 256));
            }
            GRID_BAR();
        } else {
            {
                const Params p = load_params(); const bf16_t* H = (const bf16_t*)((const char*)p.out + OUT_H);
                pg8::DenseOrder S; S.init(NTOK, DM, DM / 2, DM / 2, cx.G, (int)blockIdx.x, H, (const bf16_t*)(p.ws + WS_WSSM + (size_t)li * 6 * MiB));
                S.via_table = true;
                {
                    const int lane2 = opaque_v(lane_id()), tid2 = cx.wave * 64 + lane2; LAS unsigned* tab = (LAS unsigned*)(cx.lds + MOE_TAB + 256);
                    pg8::Unit uu; for (int i = 0; i < MAXU && S.next(i, uu); ++i) if (tid2 < 256) tab[i * 256 + tid2] = (unsigned)(uu.pm * 256 + tid2);
                    __syncthreads();
                }
                EpiU E{(bf16_t*)(p.ws + WS_R + R_US)};
                pg8::gemm_phase<EpiU, pg8::DenseOrder, true, true, true>(cx.lds, cx.wave, DM / 2, DM / 2, S, E, (volatile LAS const unsigned*)(cx.lds + MOE_TAB + 256));
            }
            GRID_BAR();
            {
                const Params p = load_params();
                SsmOrder S{cx.G, cx.vcu, 256, (const bf16_t*)(p.ws + WS_R + R_US), (const bf16_t*)(p.ws + WS_SSMM + (size_t)li * 20 * MiB + 12 * MiB), (size_t)256 * 256};
                EpiW E{(bf16_t*)(p.ws + WS_R + R_W)};
                pg8::gemm_phase<EpiW, SsmOrder, false, true>(cx.lds, cx.wave, 256, 384, S, E, nullptr);
            }
            GRID_BAR();
            { const Params p = load_params(); phase_ssm_scan(p, cx, li); }
            GRID_BAR();
            {
                const Params p = load_params();
                SsmOrder S{cx.G, cx.vcu, 384, (const bf16_t*)(p.ws + WS_R + R_US), (const bf16_t*)(p.ws + WS_SSMM + (size_t)li * 20 * MiB), (size_t)256 * 384};
                EpiY E{(bf16_t*)(p.ws + WS_R + R_YG)};
                pg8::gemm_phase<EpiY, SsmOrder, false, true>(cx.lds, cx.wave, 384, 384, S, E, nullptr);
            }
            GRID_BAR();
            {
                const Params p = load_params();
                const float* gl = (const float*)(p.ws + WS_ADA) + (size_t)l * 16 * ADA + 2048;
                pg8::DenseOrder S; S.init(NTOK, 2 * DM, DM / 2, DM / 2, cx.G, (int)blockIdx.x, (const bf16_t*)(p.ws + WS_R + R_YG), (const bf16_t*)(p.ws + WS_WSSM + (size_t)li * 6 * MiB + 2 * MiB));
                EpiGLU E{(bf16_t*)(p.ws + WS_D), gl};
                S.via_table = true;
                {
                    const int lane2 = opaque_v(lane_id()), tid2 = cx.wave * 64 + lane2; LAS unsigned* tab = (LAS unsigned*)(cx.lds + MOE_TAB + 256);
                    pg8::Unit uu; for (int i = 0; i < MAXU && S.next(i, uu); ++i) if (tid2 < 256) tab[i * 256 + tid2] = (unsigned)(uu.pm * 256 + tid2);
                    __syncthreads();
                }
                pg8::gemm_phase<EpiGLU, pg8::DenseOrder, true, true, true>(cx.lds, cx.wave, DM / 2, DM / 2, S, E, (volatile LAS const unsigned*)(cx.lds + MOE_TAB + 256));
            }
            GRID_BAR();
        }
        { const Params p = load_params(); phase_n2(p, cx, l, l); }
        GRID_BAR();
        {
            const Params p = load_params(); const bf16_t* H = (const bf16_t*)((const char*)p.out + OUT_H);
            const int nu = moe_setup<2, false>(p, cx, l);
            MoeOrder S{(LAS const int*)(cx.lds + MOE_TAB), nu, DM / 2, 0, H, (const bf16_t*)(p.ws + WS_WMOE + (size_t)l * NE * 3 * MiB / 2), 0};
            EpiSwiGLU E{(bf16_t*)((char*)p.out + OUT_HID)};
            pg8::gemm_phase<EpiSwiGLU, MoeOrder, true, true, true>(cx.lds, cx.wave, DM / 2, DM / 2, S, E, (volatile LAS const unsigned*)(cx.lds + MOE_TAB + 256));
            if (CONV_IN_TAIL && l + 1 < DEPTH) { const int TU = 2 * ((LAS const int*)(cx.lds + MOE_TAB))[MAXU * 8 + 1]; __syncthreads(); moe_tail_convert(p, cx, l + 1, TU, 0, 768); }
        }
        GRID_BAR();
        {
            const Params p = load_params();
            const int nu = moe_setup<4, true>(p, cx, l);
            MoeOrder S{(LAS const int*)(cx.lds + MOE_TAB), nu, FE / 2, 0, (const bf16_t*)((const char*)p.out + OUT_HID), (const bf16_t*)(p.ws + WS_WMOE + (size_t)l * NE * 3 * MiB / 2), (size_t)(MiB / 2)};
            EpiDown E{(bf16_t*)(p.ws + WS_R + R_Y)};
            pg8::gemm_phase<EpiDown, MoeOrder, true, true, true>(cx.lds, cx.wave, FE / 2, FE / 2, S, E, (volatile LAS const unsigned*)(cx.lds + MOE_TAB + 256 + MAXU * 256 * 8));
            if (CONV_IN_TAIL && l + 1 < DEPTH) { const int TU = 4 * ((LAS const int*)(cx.lds + MOE_TAB))[MAXU * 8 + 1]; __syncthreads(); moe_tail_convert(p, cx, l + 1, TU, 768, NE * CI_EXP); }
        }
        GRID_BAR();
    }
    { const Params p = load_params(); phase_n1<2>(p, cx, DEPTH, (const float*)(p.ws + WS_ADA) + (size_t)(DEPTH - 1) * 16 * ADA + 5120); }
}

extern "C" void kernel_launch(void* const* d_in, const int* in_sizes, int n_in, void* d_out, int out_size, void* d_ws, size_t ws_size, hipStream_t stream) {
    static int grid = 0;
    if (grid == 0) {
        if (n_in != 28 || out_size != NTOK * DM || ws_size < WS_END) { fprintf(stderr, "kernel_launch: unexpected problem (n_in %d, out %d, ws %zu < %zu); nothing launched\n", n_in, out_size, ws_size, (size_t)WS_END); grid = -1; return; }
        int dev = 0, cus = 0, per_cu = 0;
        if (hipGetDevice(&dev) != hipSuccess || hipDeviceGetAttribute(&cus, hipDeviceAttributeMultiprocessorCount, dev) != hipSuccess) { grid = -1; return; }
        if (hipFuncSetAttribute((const void*)fwd, hipFuncAttributeMaxDynamicSharedMemorySize, LDS_BYTES) != hipSuccess) { fprintf(stderr, "kernel_launch: hipFuncSetAttribute failed\n"); grid = -1; return; }
        if (hipOccupancyMaxActiveBlocksPerMultiprocessor(&per_cu, (const void*)fwd, NWAVES * 64, LDS_BYTES) != hipSuccess || per_cu < 1)
            fprintf(stderr, "kernel_launch: note: occupancy query reports %d workgroups per CU\n", per_cu);
        (void)hipGetLastError();
        grid = cus;
    }
    if (grid < 0) return;
    if (hipMemsetAsync((char*)d_ws + WS_CTL, 0, CTL_ZERO_BYTES, stream) != hipSuccess) return;
    Params p{};
    const float** pf = (const float**)&p;
    for (int i = 0; i < 28; ++i) pf[i] = (const float*)d_in[i];
    p.out = (float*)d_out; p.ws = (unsigned char*)d_ws;
    hipLaunchKernelGGL(fwd, dim3(grid), dim3(NWAVES * 64), LDS_BYTES, stream, p);
}
```

```cpp
#include <hip/hip_runtime.h>
#include <cstdio>
#include <cstdint>

#define LAS __attribute__((address_space(3)))
#define GAS __attribute__((address_space(1)))
typedef unsigned short bf16_t;
typedef short bf16x8 __attribute__((ext_vector_type(8)));
typedef float f32x4 __attribute__((ext_vector_type(4)));
typedef float f32x2 __attribute__((ext_vector_type(2)));
typedef unsigned u32x4 __attribute__((ext_vector_type(4)));
typedef unsigned u32x2 __attribute__((ext_vector_type(2)));

constexpr int NB = 16, SEQ = 2048, DM = 1024, NTOK = NB * SEQ, DEPTH = 4;
constexpr int HD = 64, NQH = 16, NKVH = 4, QKVD = 1536;
constexpr int SG = 64, SP = 64, SC = 16;
constexpr int NE = 32, FE = 256;
constexpr int ADA = 6 * DM;
constexpr float RMS_EPS = 1e-6f;

constexpr size_t MiB = 1u << 20;
constexpr size_t WS_CTL = 0, CTL_ZERO_BYTES = 1 * MiB;
constexpr size_t WS_ADA = 1 * MiB;
constexpr size_t WS_SSMP = 3 * MiB;
constexpr size_t WS_LIST = 5 * MiB;
constexpr size_t WS_WATT = 13 * MiB;
constexpr size_t WS_WSSM = 23 * MiB;
constexpr size_t WS_SSMM = 35 * MiB;
constexpr size_t WS_WMOE = 75 * MiB;
constexpr size_t WS_R = 267 * MiB;
constexpr size_t WS_D = 459 * MiB;
constexpr size_t WS_XB = 523 * MiB;
constexpr size_t WS_WR = 587 * MiB;
constexpr size_t WS_END = 590 * MiB;
constexpr size_t OUT_H = 0, OUT_HID = 64 * MiB;
constexpr size_t R_Q = 0, R_K = 64 * MiB, R_VT = 80 * MiB, R_O8 = 96 * MiB;
constexpr size_t R_US = 0, R_W = 96 * MiB, R_YG = 128 * MiB;
constexpr size_t R_Y = 0;

constexpr int CW_TMO = 0, CW_CODE = 1;
constexpr int CW_BAR = 4096;
constexpr int CW_CONV = 8192;
constexpr int CW_GCNT = 16384;

constexpr int LDS_SCR = 147456;
constexpr int RING_BYTES = 131072;
constexpr int MOE_TAB = 131072;
constexpr int N2_TAB = LDS_SCR;
constexpr int MISC_OFF = LDS_SCR + 4096;
constexpr int N2_AB = MISC_OFF + 512;
constexpr int LDS_BYTES = N2_AB + 8192;
constexpr int MAXU = 6;

constexpr int NWAVES = 8;
constexpr int GU_E1 = 192;
constexpr bool CONV_IN_TAIL = true;


__device__ __forceinline__ unsigned cvt_pk_bf16(float lo, float hi) { unsigned r; asm volatile("v_cvt_pk_bf16_f32 %0, %1, %2" : "=v"(r) : "v"(lo), "v"(hi)); return r; }
typedef float f32x2p __attribute__((ext_vector_type(2)));
__device__ __forceinline__ unsigned pack4_fp8(float a, float b, float c, float d) { int w = 0; w = __builtin_amdgcn_cvt_pk_fp8_f32(a * 16.0f, b * 16.0f, w, false); w = __builtin_amdgcn_cvt_pk_fp8_f32(c * 16.0f, d * 16.0f, w, true); return (unsigned)w; }
__device__ __forceinline__ f32x4 unpack4_fp8(unsigned w) { const f32x2p lo = __builtin_amdgcn_cvt_pk_f32_fp8((int)w, false), hi = __builtin_amdgcn_cvt_pk_f32_fp8((int)w, true); f32x4 r; r[0] = lo[0]; r[1] = lo[1]; r[2] = hi[0]; r[3] = hi[1]; return r * 0.0625f; }
__device__ __forceinline__ unsigned pack4_fp8_raw(float a, float b, float c, float d) { int w = 0; w = __builtin_amdgcn_cvt_pk_fp8_f32(a, b, w, false); w = __builtin_amdgcn_cvt_pk_fp8_f32(c, d, w, true); return (unsigned)w; }
__device__ __forceinline__ float bf_lo(unsigned w) { return __uint_as_float(w << 16); }
__device__ __forceinline__ float bf_hi(unsigned w) { return __uint_as_float(w & 0xffff0000u); }
template <int M> __device__ __forceinline__ float xor_swz(float v) { return __int_as_float(__builtin_amdgcn_ds_swizzle(__float_as_int(v), (M << 10) | 0x1f)); }
__device__ __forceinline__ float half_sum(float v) {
    const auto r = __builtin_amdgcn_permlane32_swap(__float_as_uint(v), __float_as_uint(v), false, false);
    return __uint_as_float(r[0]) + __uint_as_float(r[1]);
}
__device__ __forceinline__ float wave_sum(float v) { v += xor_swz<1>(v); v += xor_swz<2>(v); v += xor_swz<4>(v); v += xor_swz<8>(v); v += xor_swz<16>(v); return half_sum(v); }
__device__ __forceinline__ float bcast(float v, int srclane) { return __int_as_float(__builtin_amdgcn_readlane(__float_as_int(v), srclane)); }
__device__ __forceinline__ int vzero() { int z = 0; asm volatile("" : "+v"(z)); return z; }
__device__ __forceinline__ float sigmoidf_(float z) { return __builtin_amdgcn_rcpf(1.0f + __builtin_amdgcn_exp2f(-1.4426950408889634f * z)); }
__device__ __forceinline__ float gelu_tanh(float y) { const float z = 0.7978845608028654f * (y + 0.044715f * y * y * y); const float t = 1.0f - 2.0f * __builtin_amdgcn_rcpf(1.0f + __builtin_amdgcn_exp2f(2.885390081777927f * z)); return 0.5f * y * (1.0f + t); }

__device__ __forceinline__ int lane_id();
#define XB_TMO      128
#define XB_XCNT(j)  (256  + 64 * (j))
#define XB_XSUB(j)  (1280 + 64 * (j))
#define XB_XGEN(j)  (2304 + 64 * (j))
#define XB_TOP      3328
#define XB_TOPGEN   3392
#define XCD_BAR_WORDS 3456
#define XB_SPIN_CAP (1u << 18)
typedef GAS unsigned gu32;
__device__ __forceinline__ unsigned xb_ld(gu32* p)              { return __hip_atomic_load(p, __ATOMIC_RELAXED, __HIP_MEMORY_SCOPE_AGENT); }
__device__ __forceinline__ unsigned xb_add(gu32* p, unsigned v) { return __hip_atomic_fetch_add(p, v, __ATOMIC_RELAXED, __HIP_MEMORY_SCOPE_AGENT); }
__device__ __forceinline__ unsigned xb_xcc_id() { return (unsigned)__builtin_amdgcn_s_getreg((3 << 11) | 20) & 0xFu; }
#define XB_SPIN(cond, bar) do { unsigned _sp = 0; while (cond) { __builtin_amdgcn_s_sleep(1); \
    if ((++_sp & 255u) == 0u) { if (xb_ld(&(bar)[XB_TMO])) break; if (_sp > XB_SPIN_CAP) { (void)xb_add(&(bar)[XB_TMO], 1u); break; } } } } while (0)
struct XcdBarrier { gu32* bar; unsigned x; volatile LAS unsigned* st; };
__device__ __forceinline__ XcdBarrier xcd_barrier_post(gu32* bar, volatile LAS unsigned* st) {
    XcdBarrier b; b.bar = bar; b.x = xb_xcc_id(); b.st = st;
    if (threadIdx.x == 0) (void)xb_add(&bar[XB_XCNT(b.x)], 1u);
    return b;
}
__device__ __forceinline__ void xcd_barrier_complete(gu32* bar, unsigned x, unsigned& nloc, unsigned& nx) {
    const unsigned G = gridDim.x * gridDim.y * gridDim.z;
    unsigned sum, cnt, mine, sp = 0u;
    for (;;) {
        sum = 0u; cnt = 0u; mine = 0u;
#pragma unroll
        for (unsigned j = 0; j < 16; ++j) { const unsigned c = xb_ld(&bar[XB_XCNT(j)]); sum += c; cnt += (c > 0u) ? 1u : 0u; mine = (j == x) ? c : mine; }
        if (sum == G) break;
        __builtin_amdgcn_s_sleep(1);
        if ((++sp & 255u) == 0u) { if (xb_ld(&bar[XB_TMO])) break; if (sp > XB_SPIN_CAP) { (void)xb_add(&bar[XB_TMO], 1u); break; } }
    }
    nloc = mine > 0u ? mine : 1u; nx = cnt > 0u ? cnt : 1u;
}
template <bool FIRST>
__device__ __forceinline__ void xcd_barrier(const XcdBarrier& b, const int wave) {
    asm volatile("s_waitcnt vmcnt(0)" ::: "memory");
    __syncthreads();
    if (wave == 0 && lane_id() == 0) {
        gu32* bar = b.bar; unsigned bx = b.x;
        asm volatile("" : "+s"(bar), "+s"(bx));
        __builtin_amdgcn_s_waitcnt(0);
        unsigned nloc = b.st[0], nx = b.st[1];
        if (FIRST) { if (nloc == 0u) { xcd_barrier_complete(bar, bx, nloc, nx); b.st[0] = nloc; b.st[1] = nx; } }
        const unsigned old = xb_add(&bar[XB_XSUB(bx)], 1u);
        const unsigned gen = old / nloc;
        if (old + 1u == (gen + 1u) * nloc) {
            __builtin_amdgcn_fence(__ATOMIC_RELEASE, "agent");
            asm volatile("s_waitcnt vmcnt(0)" ::: "memory");
            const unsigned og = xb_add(&bar[XB_TOP], 1u);
            const unsigned tg = og / nx;
            if (og + 1u == (tg + 1u) * nx) xb_add(&bar[XB_TOPGEN], 1u);
            else XB_SPIN(xb_ld(&bar[XB_TOPGEN]) == tg, bar);
            __builtin_amdgcn_fence(__ATOMIC_ACQUIRE, "agent");
            xb_add(&bar[XB_XGEN(bx)], 1u);
            asm volatile("s_waitcnt vmcnt(0)" ::: "memory");
        } else {
            XB_SPIN(xb_ld(&bar[XB_XGEN(bx)]) == gen, bar);
            __builtin_amdgcn_fence(__ATOMIC_ACQUIRE, "agent");
            asm volatile("s_waitcnt vmcnt(0)" ::: "memory");
        }
    }
    __syncthreads();
}

namespace pg8 {
constexpr int BM = 256, BK = 64, HALF = 128, HTB = HALF * BK * 2, STAGE_BYTES = 8 * HTB, NXCD = 8, WGM = 8;
__host__ __device__ __forceinline__ int lds_byte(int r, int c) { const int st = (r >> 4) * 2 + (c >> 5), rr = r & 15, cc = c & 31, ob = rr * 64 + cc * 2; return st * 1024 + (ob ^ (((ob >> 9) & 1) << 5)); }
__host__ __device__ __forceinline__ void stage_rc(int b, int& R, int& C) { const int st = b / 1024, sb = b % 1024, swz = sb ^ (((sb >> 9) & 1) << 5); R = (st >> 1) * 16 + swz / 64; C = (st & 1) * 32 + (swz % 64) / 2; }
__host__ __device__ __forceinline__ int perm32(int rho) { const int n = rho >> 4, i = rho & 15; return 8 * (i >> 2) + 4 * n + (i & 3); }

struct Unit { int pm, pn, ui; const bf16_t* A; const bf16_t* Bt; };

template <class Epi, class Sched, bool GATHER, bool ALIGN_EPI, bool FP8 = false, bool IDENT = false>
__device__ __forceinline__ void gemm_phase(LAS unsigned char* lds, const int wid, const int K, const int lda, const Sched& S, const Epi& E, volatile LAS const unsigned* gtab) {
    int lane = lane_id(); asm volatile("" : "+v"(lane));
    const int tid = wid * 64 + lane, wr = wid >> 2, wc = wid & 3, fr = lane & 15, fq = lane >> 4;
    const int nt = K / BK;
    unsigned voffA[2], voffB[2]; int Rr[2];
#pragma unroll
    for (int i = 0; i < 2; ++i) { int R, C; stage_rc(tid * 16 + i * 8192, R, C); const int Rb = Epi::PERM ? ((R & ~31) + perm32(R & 31)) : R;
        Rr[i] = R; voffA[i] = GATHER ? 0u : (unsigned)(R * lda + C) * 2u; voffB[i] = (unsigned)(Rb * K + C) * 2u; }
    const size_t hstepB = (size_t)HALF * K * 2, hstepA = (size_t)HALF * lda * 2;
    const unsigned rowb = (unsigned)lda * 2u;
    const int rsh = __builtin_amdgcn_readfirstlane(__builtin_ctz(rowb));
    const unsigned ldsw = (unsigned)wid * 1024u;
    const int aoff = lds_byte(wr * 64 + fr, fq * 8), boff = lds_byte(wc * 32 + fr, fq * 8);
#define PG8_SA(b, h) (((b) * 2 + (h)) * HTB)
#define PG8_SB(b, h) ((4 + (b) * 2 + (h)) * HTB)
#define PG8_STAGE(bufoff, gbase, voff) do { _Pragma("unroll") for (int _i = 0; _i < 2; ++_i) \
        __builtin_amdgcn_global_load_lds((const unsigned*)((const char*)(gbase) + (voff)[_i]), (LAS unsigned*)(lds + (bufoff) + ldsw + _i * 8192), 16, 0, 0); } while (0)
#define PG8_GTOK(dst, uidx, pm_, half) do { if constexpr (GATHER) { int l_ = lane; asm volatile("" : "+v"(l_)); \
        const unsigned c2_ = (unsigned)(((l_ & 3) << 4) ^ (l_ & 32)) + (unsigned)((wid & 1) * 64);     \
        if constexpr (IDENT) { dst[0] = ((unsigned)(l_ >> 2) << rsh) + c2_ + ((unsigned)((pm_) * 256 + (half) * 128 + (wid >> 1) * 16) << rsh); dst[1] = dst[0] + (64u << rsh); } \
        else { const int ri_ = (uidx) * 256 + (half) * 128 + (wid >> 1) * 16 + (l_ >> 2); dst[0] = gtab[ri_] + c2_; dst[1] = gtab[ri_ + 64] + c2_; } } } while (0)
#define PG8_LDA(dst, b, h) do { if constexpr (FP8) { _Pragma("unroll") for (int m = 0; m < 4; ++m) dst##8[m] = __builtin_shufflevector(*(const LAS v4i_*)(lds + PG8_SA(b, h) + aoff + m * 2048), *(const LAS v4i_*)(lds + PG8_SA(b, h) + aoff + m * 2048 + 1024), 0, 1, 2, 3, 4, 5, 6, 7); } \
        else { _Pragma("unroll") for (int m = 0; m < 4; ++m) _Pragma("unroll") for (int k = 0; k < 2; ++k) dst[m][k] = *(const LAS bf16x8*)(lds + PG8_SA(b, h) + aoff + m * 2048 + k * 1024); } } while (0)
#define PG8_LDB(dst, b, h) do { if constexpr (FP8) { _Pragma("unroll") for (int n = 0; n < 2; ++n) dst##8[n] = __builtin_shufflevector(*(const LAS v4i_*)(lds + PG8_SB(b, h) + boff + n * 2048), *(const LAS v4i_*)(lds + PG8_SB(b, h) + boff + n * 2048 + 1024), 0, 1, 2, 3, 4, 5, 6, 7); } \
        else { _Pragma("unroll") for (int n = 0; n < 2; ++n) _Pragma("unroll") for (int k = 0; k < 2; ++k) dst[n][k] = *(const LAS bf16x8*)(lds + PG8_SB(b, h) + boff + n * 2048 + k * 1024); } } while (0)
#define PG8_MMA(ai, bj, At, Bt) do { __builtin_amdgcn_s_setprio(1); _Pragma("unroll") for (int m = 0; m < 4; ++m) _Pragma("unroll") for (int n = 0; n < 2; ++n) { \
        if constexpr (FP8) acc[ai][bj][m][n] = __builtin_amdgcn_mfma_scale_f32_16x16x128_f8f6f4(Bt##8[n], At##8[m], acc[ai][bj][m][n], 0, 0, 0, 0x7f7f7f7f, 0, 0x7f7f7f7f); \
        else { _Pragma("unroll") for (int k = 0; k < 2; ++k) acc[ai][bj][m][n] = __builtin_amdgcn_mfma_f32_16x16x32_bf16(Bt[n][k], At[m][k], acc[ai][bj][m][n], 0, 0, 0); } } \
        __builtin_amdgcn_s_setprio(0); } while (0)
#define PG8_WAIT_V(n) asm volatile("s_waitcnt vmcnt(" #n ")" ::: "memory")
#define PG8_WAIT_L(n) asm volatile("s_waitcnt lgkmcnt(" #n ")" ::: "memory")
#define PG8_BAR __builtin_amdgcn_s_barrier()
#define PG8_SCHED __builtin_amdgcn_sched_barrier(0)
    Unit cur, nxt; int ui = 0;
    if (!S.next(0, cur)) return;
    f32x4 acc[2][2][4][2];
#pragma unroll
    for (int a = 0; a < 2; ++a)
#pragma unroll
        for (int b = 0; b < 2; ++b)
#pragma unroll
            for (int m = 0; m < 4; ++m)
#pragma unroll
                for (int n = 0; n < 2; ++n) acc[a][b][m][n] = (f32x4){0.f, 0.f, 0.f, 0.f};
    typedef int v4i_ __attribute__((ext_vector_type(4))); typedef int v8i_ __attribute__((ext_vector_type(8)));
    bf16x8 At[4][2], B0[2][2], B1[2][2];
    v8i_ At8[4], B08[2], B18[2];
    unsigned go[2];
    const char* cA = (const char*)cur.A; const char* cB = (const char*)cur.Bt;
    PG8_STAGE(PG8_SB(0, 0), cB, voffB); PG8_STAGE(PG8_SB(0, 1), cB + hstepB, voffB);
    if constexpr (GATHER) { PG8_GTOK(go, 0, cur.pm, 0); PG8_STAGE(PG8_SA(0, 0), cA, go); PG8_GTOK(go, 0, cur.pm, 1); PG8_STAGE(PG8_SA(0, 1), cA, go); }
    else { PG8_STAGE(PG8_SA(0, 0), cA, voffA); PG8_STAGE(PG8_SA(0, 1), cA + hstepA, voffA); }
    PG8_STAGE(PG8_SB(1, 0), cB + 128, voffB);
    if constexpr (GATHER) { PG8_GTOK(go, 0, cur.pm, 0); PG8_STAGE(PG8_SA(1, 0), cA + 128, go); } else { PG8_STAGE(PG8_SA(1, 0), cA + 128, voffA); }
    PG8_STAGE(PG8_SB(1, 1), cB + hstepB + 128, voffB);
    if (wr == 1) PG8_BAR;
    PG8_WAIT_V(8); PG8_BAR;
    PG8_WAIT_V(6); PG8_BAR;
    for (;;) {
        const bool has_next = S.next(ui + 1, nxt);
        const char* nA = has_next ? (const char*)nxt.A : cA; const char* nB = has_next ? (const char*)nxt.Bt : cB;
        const int nui = has_next ? ui + 1 : ui;
#pragma nounroll
        for (int t = 0; t < nt; t += 2) {
            const bool last = (t == nt - 2);
            const char* a1 = cA + (size_t)(t + 1) * 128;
            const char* a2 = last ? nA : cA + (size_t)(t + 2) * 128; const char* b2 = last ? nB : cB + (size_t)(t + 2) * 128;
            const char* a3 = a2 + 128; const char* b3 = b2 + 128;
            const int u2 = last ? nui : ui; const int pm2 = (last && has_next) ? nxt.pm : cur.pm;
            PG8_GTOK(go, ui, cur.pm, 1);
            PG8_LDB(B0, 0, 0); PG8_LDB(B1, 0, 1); PG8_SCHED; PG8_LDA(At, 0, 0);
            if constexpr (GATHER) { PG8_STAGE(PG8_SA(1, 1), a1, go); } else { PG8_STAGE(PG8_SA(1, 1), a1 + hstepA, voffA); }
            PG8_WAIT_V(8); PG8_WAIT_L(0); PG8_BAR; PG8_MMA(0, 0, At, B0); PG8_MMA(0, 1, At, B1); PG8_BAR; PG8_SCHED;
            PG8_GTOK(go, u2, pm2, 0);
            if constexpr (IDENT) { PG8_STAGE(PG8_SB(0, 0), b2, voffB); PG8_STAGE(PG8_SB(0, 1), b2 + hstepB, voffB); PG8_STAGE(PG8_SA(0, 0), a2, go); PG8_SCHED; PG8_LDA(At, 0, 1); }
            else if constexpr (GATHER && FP8) { PG8_STAGE(PG8_SB(0, 0), b2, voffB); PG8_STAGE(PG8_SB(0, 1), b2 + hstepB, voffB); PG8_SCHED; PG8_LDA(At, 0, 1); PG8_STAGE(PG8_SA(0, 0), a2, go); }
            else { PG8_LDA(At, 0, 1); PG8_STAGE(PG8_SB(0, 0), b2, voffB); PG8_STAGE(PG8_SB(0, 1), b2 + hstepB, voffB);
                if constexpr (GATHER) { PG8_STAGE(PG8_SA(0, 0), a2, go); } else { PG8_STAGE(PG8_SA(0, 0), a2, voffA); } }
            PG8_WAIT_V(8); PG8_WAIT_L(0); PG8_BAR; PG8_MMA(1, 0, At, B0); PG8_MMA(1, 1, At, B1); PG8_BAR; PG8_SCHED;
            PG8_GTOK(go, u2, pm2, 1);
            PG8_LDB(B0, 1, 0); PG8_LDB(B1, 1, 1); PG8_SCHED; PG8_LDA(At, 1, 0);
            if constexpr (GATHER) { PG8_STAGE(PG8_SA(0, 1), a2, go); } else { PG8_STAGE(PG8_SA(0, 1), a2 + hstepA, voffA); }
            PG8_WAIT_V(8); PG8_WAIT_L(0); PG8_BAR; PG8_MMA(0, 0, At, B0); PG8_MMA(0, 1, At, B1); PG8_BAR; PG8_SCHED;
            PG8_GTOK(go, u2, pm2, 0);
            if constexpr (IDENT) { PG8_STAGE(PG8_SB(1, 0), b3, voffB); PG8_STAGE(PG8_SB(1, 1), b3 + hstepB, voffB); PG8_STAGE(PG8_SA(1, 0), a3, go); PG8_SCHED; PG8_LDA(At, 1, 1); }
            else if constexpr (GATHER && FP8) { PG8_STAGE(PG8_SB(1, 0), b3, voffB); PG8_STAGE(PG8_SB(1, 1), b3 + hstepB, voffB); PG8_SCHED; PG8_LDA(At, 1, 1); PG8_STAGE(PG8_SA(1, 0), a3, go); }
            else { PG8_LDA(At, 1, 1); PG8_STAGE(PG8_SB(1, 0), b3, voffB); PG8_STAGE(PG8_SB(1, 1), b3 + hstepB, voffB);
                if constexpr (GATHER) { PG8_STAGE(PG8_SA(1, 0), a3, go); } else { PG8_STAGE(PG8_SA(1, 0), a3, voffA); } }
            PG8_WAIT_V(8); PG8_WAIT_L(0); PG8_BAR; PG8_MMA(1, 0, At, B0); PG8_MMA(1, 1, At, B1); PG8_BAR; PG8_SCHED;
        }
        if constexpr (ALIGN_EPI) { if (wr == 0) PG8_BAR; }
        E(acc, cur, wr, wc, fr, fq, lds);
        if (!has_next) break;
#pragma unroll
        for (int a = 0; a < 2; ++a)
#pragma unroll
            for (int b = 0; b < 2; ++b)
#pragma unroll
                for (int m = 0; m < 4; ++m)
#pragma unroll
                    for (int n = 0; n < 2; ++n) acc[a][b][m][n] = (f32x4){0.f, 0.f, 0.f, 0.f};
        cur = nxt; cA = nA; cB = nB; ++ui;
        if constexpr (ALIGN_EPI) { if (wr == 1) PG8_BAR; }
    }
    PG8_WAIT_V(0);
    if constexpr (!ALIGN_EPI) { if (wr == 0) PG8_BAR; }
    PG8_BAR;
#undef PG8_SA
#undef PG8_SB
#undef PG8_STAGE
#undef PG8_GTOK
#undef PG8_LDA
#undef PG8_LDB
#undef PG8_MMA
#undef PG8_WAIT_V
#undef PG8_WAIT_L
#undef PG8_BAR
#undef PG8_SCHED
}

struct DenseOrder {
    int nM, nN, nwg, G, c, K, lda; const bf16_t* A; const bf16_t* Bt; bool via_table = false;
    __device__ __forceinline__ void init(int M, int N, int K_, int lda_, int G_, int c_, const bf16_t* A_, const bf16_t* Bt_) { nM = M / BM; nN = N / BM; nwg = nM * nN; G = G_; c = c_; K = K_; lda = lda_; A = A_; Bt = Bt_; }
    __device__ __forceinline__ bool next(int i, Unit& u) const {
        const long L = (long)i * G + c; if (L >= nwg) return false;
        int wgid = (int)L; { const int q = nwg / NXCD, r = nwg % NXCD, xcd = wgid % NXCD, off = wgid / NXCD; wgid = (xcd < r ? xcd * (q + 1) : r * (q + 1) + (xcd - r) * q) + off; }
        const int nig = WGM * nN, gid = wgid / nig, fm = gid * WGM, gsz = (nM - fm) < WGM ? (nM - fm) : WGM;
        u.pm = fm + ((wgid % nig) % gsz); u.pn = (wgid % nig) / gsz; u.ui = i; u.A = via_table ? A : A + (size_t)u.pm * BM * lda; u.Bt = Bt + (size_t)u.pn * BM * K; return true;
    }
};
}

struct Params {
    const float* x; const float* c; const float* norm_mix; const float* norm_ffn; const float* w_ada; const float* b_ada;
    const float* attn_w_qkv; const float* attn_q_gain; const float* attn_k_gain; const float* attn_sinks; const float* attn_w_o;
    const float* ssm_w_in; const float* ssm_lam_re; const float* ssm_lam_im; const float* ssm_log_dt; const float* ssm_b_re; const float* ssm_b_im;
    const float* ssm_c_re; const float* ssm_c_im; const float* ssm_d; const float* ssm_w_glu;
    const float* moe_w_group; const float* moe_b_group; const float* moe_w_expert; const float* moe_b_expert;
    const float* moe_w_gate; const float* moe_w_up; const float* moe_w_down;
    float* out; unsigned char* ws;
};

__device__ __forceinline__ Params load_params() {
    Params p{};
#if defined(__HIP_DEVICE_COMPILE__)
    typedef GAS char* gptr_t;
    typedef __attribute__((address_space(4))) const gptr_t* KP;
    KP kp = (KP)__builtin_amdgcn_kernarg_segment_ptr();
    asm volatile("" : "+s"(kp));
    p.x = (const float*)kp[0]; p.c = (const float*)kp[1]; p.norm_mix = (const float*)kp[2]; p.norm_ffn = (const float*)kp[3]; p.w_ada = (const float*)kp[4]; p.b_ada = (const float*)kp[5];
    p.attn_w_qkv = (const float*)kp[6]; p.attn_q_gain = (const float*)kp[7]; p.attn_k_gain = (const float*)kp[8]; p.attn_sinks = (const float*)kp[9]; p.attn_w_o = (const float*)kp[10];
    p.ssm_w_in = (const float*)kp[11]; p.ssm_lam_re = (const float*)kp[12]; p.ssm_lam_im = (const float*)kp[13]; p.ssm_log_dt = (const float*)kp[14]; p.ssm_b_re = (const float*)kp[15]; p.ssm_b_im = (const float*)kp[16];
    p.ssm_c_re = (const float*)kp[17]; p.ssm_c_im = (const float*)kp[18]; p.ssm_d = (const float*)kp[19]; p.ssm_w_glu = (const float*)kp[20];
    p.moe_w_group = (const float*)kp[21]; p.moe_b_group = (const float*)kp[22]; p.moe_w_expert = (const float*)kp[23]; p.moe_b_expert = (const float*)kp[24];
    p.moe_w_gate = (const float*)kp[25]; p.moe_w_up = (const float*)kp[26]; p.moe_w_down = (const float*)kp[27];
    p.out = (float*)kp[28]; p.ws = (unsigned char*)kp[29];
#endif
    return p;
}
__device__ __forceinline__ int opaque_v(int v) { asm volatile("" : "+v"(v)); return v; }
__device__ __forceinline__ int lane_id() { int l; asm volatile("v_mbcnt_lo_u32_b32 %0, -1, 0\n\tv_mbcnt_hi_u32_b32 %0, -1, %0" : "=v"(l)); return l; }

using pg8::Unit;
typedef f32x4 AccT[2][2][4][2];

struct EpiQKV {
    static constexpr bool PERM = true;
    bf16_t* Q; bf16_t* Kb; bf16_t* Vt;
    __device__ __forceinline__ void operator()(const AccT& acc, const Unit& u, int wr, int wc, int fr, int fq, LAS unsigned char*) const {
        const int row0 = u.pm * 256 + wr * 64 + fr, cl = wc * 32 + 8 * fq;
#pragma unroll
        for (int ai = 0; ai < 2; ++ai)
#pragma unroll
            for (int m = 0; m < 4; ++m) {
                const int row = row0 + ai * 128 + m * 16;
#pragma unroll
                for (int bj = 0; bj < 2; ++bj) {
                    const f32x4 v0 = acc[ai][bj][m][0] * 0.0625f, v1 = acc[ai][bj][m][1] * 0.0625f;
                    u32x4 w; w.x = cvt_pk_bf16(v0[0], v0[1]); w.y = cvt_pk_bf16(v0[2], v0[3]); w.z = cvt_pk_bf16(v1[0], v1[1]); w.w = cvt_pk_bf16(v1[2], v1[3]);
                    const int col = bj * 128 + cl;
                    if (u.pn < 4) { *(u32x4*)((char*)Q + (unsigned)(row * 1024 + u.pn * 256 + col) * 2u) = w; }
                    else if (u.pn == 4) { *(u32x4*)((char*)Kb + (unsigned)(row * 256 + col) * 2u) = w; }
                    else {
                        const int b = row >> 11, t0 = row & 2047, t = (t0 & ~31) | ((((t0 >> 2) & 1) << 4) + (((t0 >> 3) & 3) << 2) + (t0 & 3)), kvh = col >> 6, d0 = col & 63;
                        bf16_t* vp = (bf16_t*)((char*)Vt + (unsigned)((((b * 4 + kvh) * 64 + d0)) * 2048 + t) * 2u);
                        vp[0 * 2048] = (bf16_t)(w.x & 0xffffu); vp[1 * 2048] = (bf16_t)(w.x >> 16);
                        vp[2 * 2048] = (bf16_t)(w.y & 0xffffu); vp[3 * 2048] = (bf16_t)(w.y >> 16);
                        vp[4 * 2048] = (bf16_t)(w.z & 0xffffu); vp[5 * 2048] = (bf16_t)(w.z >> 16);
                        vp[6 * 2048] = (bf16_t)(w.w & 0xffffu); vp[7 * 2048] = (bf16_t)(w.w >> 16);
                    }
                }
            }
    }
};
struct EpiDelta {
    static constexpr bool PERM = true;
    bf16_t* D; const float* gate_l;
    __device__ __forceinline__ void operator()(const AccT& acc, const Unit& u, int wr, int wc, int fr, int fq, LAS unsigned char* lds) const {
        const int row0 = u.pm * 256 + wr * 64 + fr, col0 = u.pn * 256 + wc * 32 + 8 * fq;
        const LAS float* gp = (const LAS float*)(lds + MOE_TAB) + u.ui * 256 + wc * 32 + 8 * fq;
        f32x4 gv[2][2];
#pragma unroll
        for (int bj = 0; bj < 2; ++bj)
#pragma unroll
            for (int n = 0; n < 2; ++n) gv[bj][n] = *(const LAS f32x4*)(gp + bj * 128 + n * 4) * (1.0f / 256.0f);
#pragma unroll
        for (int ai = 0; ai < 2; ++ai)
#pragma unroll
            for (int m = 0; m < 4; ++m) { bf16_t* rowp = (bf16_t*)((char*)D + (unsigned)((row0 + ai * 128 + m * 16) * 1024 + col0) * 2u);
#pragma unroll
                for (int bj = 0; bj < 2; ++bj) { const f32x4 v0 = acc[ai][bj][m][0] * gv[bj][0], v1 = acc[ai][bj][m][1] * gv[bj][1];
                    u32x4 w; w.x = cvt_pk_bf16(v0[0], v0[1]); w.y = cvt_pk_bf16(v0[2], v0[3]); w.z = cvt_pk_bf16(v1[0], v1[1]); w.w = cvt_pk_bf16(v1[2], v1[3]);
                    *(u32x4*)(rowp + bj * 128) = w; } }
    }
};
struct EpiGLU {
    static constexpr bool PERM = true;
    bf16_t* D; const float* gate_l;
    __device__ __forceinline__ void operator()(const AccT& acc, const Unit& u, int wr, int wc, int fr, int fq, LAS unsigned char* lds) const {
        int pm_ = u.pm; asm volatile("" : "+s"(pm_));
        const int row0 = pm_ * 256 + wr * 64 + fr, col0 = u.pn * 128 + wc * 32 + 8 * fq;
        const LAS float* gp = (const LAS float*)(lds + MOE_TAB) + u.ui * 256 + wc * 32 + 8 * fq;
        f32x4 gv[2];
#pragma unroll
        for (int n = 0; n < 2; ++n) gv[n] = *(const LAS f32x4*)(gp + n * 4);
#pragma unroll
        for (int ai = 0; ai < 2; ++ai)
#pragma unroll
            for (int m = 0; m < 4; ++m) { float o[8];
#pragma unroll
                for (int n = 0; n < 2; ++n)
#pragma unroll
                    for (int j = 0; j < 4; ++j) o[n * 4 + j] = gv[n][j] * (acc[ai][0][m][n][j] * 0.0625f) * sigmoidf_(acc[ai][1][m][n][j] * 0.0625f);
                u32x4 w; w.x = cvt_pk_bf16(o[0], o[1]); w.y = cvt_pk_bf16(o[2], o[3]); w.z = cvt_pk_bf16(o[4], o[5]); w.w = cvt_pk_bf16(o[6], o[7]);
                *(u32x4*)((char*)D + (unsigned)((row0 + ai * 128 + m * 16) * 1024 + col0) * 2u) = w; }
    }
};
struct EpiU {
    static constexpr bool PERM = true;
    bf16_t* US;
    __device__ __forceinline__ void operator()(const AccT& acc, const Unit& u, int wr, int wc, int fr, int fq, LAS unsigned char*) const {
        const int row0 = u.pm * 256 + wr * 64 + fr;
#pragma unroll
        for (int ai = 0; ai < 2; ++ai)
#pragma unroll
            for (int m = 0; m < 4; ++m) {
                const int row = row0 + ai * 128 + m * 16, b = row >> 11, t = row & 2047;
#pragma unroll
                for (int bj = 0; bj < 2; ++bj) {
                    const f32x4 v0 = acc[ai][bj][m][0] * 0.0625f, v1 = acc[ai][bj][m][1] * 0.0625f;
                    u32x4 w; w.x = cvt_pk_bf16(v0[0], v0[1]); w.y = cvt_pk_bf16(v0[2], v0[3]); w.z = cvt_pk_bf16(v1[0], v1[1]); w.w = cvt_pk_bf16(v1[2], v1[3]);
                    const int c0 = u.pn * 256 + bj * 128 + wc * 32 + 8 * fq, g = c0 >> 4, ci0 = c0 & 15;
                    *(u32x4*)((char*)US + (unsigned)((g * 2048 + b * 128 + (t >> 4)) * 384 + (t & 15) * 16 + ci0) * 2u) = w;
                }
            }
    }
};
struct EpiSwiGLU {
    static constexpr bool PERM = true;
    bf16_t* HID;
    __device__ __forceinline__ void operator()(const AccT& acc, const Unit& u, int wr, int wc, int fr, int fq, LAS unsigned char*) const {
        const int row0 = u.pm * 256 + wr * 64 + fr, col0 = u.pn * 128 + wc * 32 + 8 * fq;
#pragma unroll
        for (int ai = 0; ai < 2; ++ai)
#pragma unroll
            for (int m = 0; m < 4; ++m) {
                float h[8];
#pragma unroll
                for (int n = 0; n < 2; ++n)
#pragma unroll
                    for (int j = 0; j < 4; ++j) { const float g = acc[ai][0][m][n][j] * 0.0625f, up = acc[ai][1][m][n][j] * 0.0625f; h[n * 4 + j] = g * sigmoidf_(g) * up; }
                u32x2 w; w.x = pack4_fp8_raw(h[0] * 8.f, h[1] * 8.f, h[2] * 8.f, h[3] * 8.f); w.y = pack4_fp8_raw(h[4] * 8.f, h[5] * 8.f, h[6] * 8.f, h[7] * 8.f);
                *(u32x2*)((unsigned char*)HID + (unsigned)((row0 + ai * 128 + m * 16) * 256 + col0)) = w;
            }
    }
};
struct EpiDown {
    static constexpr bool PERM = true;
    bf16_t* Y;
    __device__ __forceinline__ void operator()(const AccT& acc, const Unit& u, int wr, int wc, int fr, int fq, LAS unsigned char* lds) const {
        int rb_ = wr * 64 + fr; asm volatile("" : "+v"(rb_));
        const LAS u32x2* tab = (const LAS u32x2*)(lds + MOE_TAB + 256) + u.ui * 256 + rb_;
        const int col0 = u.pn * 256 + wc * 32 + 8 * fq;
        u32x2 ents[2][4];
#pragma unroll
        for (int ai = 0; ai < 2; ++ai)
#pragma unroll
            for (int m = 0; m < 4; ++m) ents[ai][m] = tab[ai * 128 + m * 16];
#pragma unroll
        for (int ai = 0; ai < 2; ++ai)
#pragma unroll
            for (int m = 0; m < 4; ++m) {
                const u32x2 ent = ents[ai][m];
                if (ent.x != 0xffffffffu) {
                    const float gate = __uint_as_float(ent.y) * (1.0f / 128.0f);
                    unsigned char* dst = (unsigned char*)Y + (((ent.x & 1u) * (unsigned)NTOK + (ent.x >> 1)) * 1024u + (unsigned)col0);
#pragma unroll
                    for (int bj = 0; bj < 2; ++bj) {
                        const f32x4 v0 = acc[ai][bj][m][0] * gate, v1 = acc[ai][bj][m][1] * gate;
                        u32x2 w; w.x = pack4_fp8(v0[0], v0[1], v0[2], v0[3]); w.y = pack4_fp8(v1[0], v1[1], v1[2], v1[3]);
                        *(u32x2*)(dst + bj * 128) = w;
                    }
                }
            }
    }
};

struct SsmOrder {
    int G, c, K; const bf16_t* US; const bf16_t* Bm; size_t bstride;
    __device__ __forceinline__ bool next(int i, Unit& u) const {
        const int L = i * G + c; if (L >= SG * 8) return false;
        u.pm = L; u.pn = 0; u.ui = i; u.A = US + (size_t)L * 256 * 384; u.Bt = Bm + (size_t)(L >> 3) * bstride; return true;
    }
};
struct EpiW {
    static constexpr bool PERM = true;
    bf16_t* W;
    __device__ __forceinline__ void operator()(const AccT& acc, const Unit& u, int wr, int wc, int fr, int fq, LAS unsigned char*) const {
        const int row0 = u.pm * 256 + wr * 64 + fr, col0 = wc * 32 + 8 * fq;
#pragma unroll
        for (int ai = 0; ai < 2; ++ai)
#pragma unroll
            for (int m = 0; m < 4; ++m) { const f32x4 v0 = acc[ai][0][m][0], v1 = acc[ai][0][m][1];
                u32x4 w; w.x = cvt_pk_bf16(v0[0], v0[1]); w.y = cvt_pk_bf16(v0[2], v0[3]); w.z = cvt_pk_bf16(v1[0], v1[1]); w.w = cvt_pk_bf16(v1[2], v1[3]);
                *(u32x4*)((char*)W + (unsigned)((row0 + ai * 128 + m * 16) * 128 + col0) * 2u) = w; }
    }
};
struct EpiY {
    static constexpr bool PERM = true;
    bf16_t* YG;
    __device__ __forceinline__ void operator()(const AccT& acc, const Unit& u, int wr, int wc, int fr, int fq, LAS unsigned char*) const {
        const int g = u.pm >> 3, rowg0 = (u.pm & 7) * 256 + wr * 64 + fr;
#pragma unroll
        for (int ai = 0; ai < 2; ++ai)
#pragma unroll
            for (int m = 0; m < 4; ++m) {
                const int rowg = rowg0 + ai * 128 + m * 16, b = rowg >> 7, k = rowg & 127;
#pragma unroll
                for (int bj = 0; bj < 2; ++bj) {
                    const f32x4 v0 = acc[ai][bj][m][0], v1 = acc[ai][bj][m][1];
                    u32x2 w; w.x = pack4_fp8_raw(gelu_tanh(v0[0]), gelu_tanh(v0[1]), gelu_tanh(v0[2]), gelu_tanh(v0[3])); w.y = pack4_fp8_raw(gelu_tanh(v1[0]), gelu_tanh(v1[1]), gelu_tanh(v1[2]), gelu_tanh(v1[3]));
                    const int col = bj * 128 + wc * 32 + 8 * fq, t = col >> 4, co0 = col & 15;
                    *(u32x2*)((unsigned char*)YG + (unsigned)((b * 2048 + 16 * k + t) * 1024 + g * 16 + co0)) = w;
                }
            }
    }
};

struct MoeOrder {
    LAS const int* utab; int nunits, K, dense_lda; const bf16_t* A; const bf16_t* Wl; size_t boff;
    __device__ __forceinline__ bool next(int i, Unit& u) const {
        if (i >= nunits) return false;
        const LAS int* t = utab + i * 8;
        u.pm = __builtin_amdgcn_readfirstlane(t[0]); u.pn = __builtin_amdgcn_readfirstlane(t[1]); const int e = __builtin_amdgcn_readfirstlane(t[2]); u.ui = i;
        u.A = A + (size_t)u.pm * 256 * dense_lda; u.Bt = Wl + (size_t)e * 786432 + boff + (size_t)u.pn * 256 * K; return true;
    }
};

struct Ctx { LAS unsigned char* lds; int wave, vcu, G, gw, NGW; };

constexpr int CI_QKV = 16 * 6, CI_SQ = 16 * 4, CI_GLU = 16 * 8, CI_ATT = CI_QKV + CI_SQ, CI_SSM = CI_SQ + CI_GLU, CI_EXP = 48;
constexpr int CI_DENSE = 2 * CI_ATT + 2 * CI_SSM;
__device__ __forceinline__ void conv_range(const Params& p, const Ctx& cx, const int tid_, const int cbeg, const int cend) {
    f32x4 preA[8], preB[8];
    const float* srcA = nullptr; bf16_t* dstA = nullptr; int KA = 0, NA = 0, k0A = 0, n0A = 0, modeA = 0;
    const float* srcB = nullptr; bf16_t* dstB = nullptr; int KB = 0, NB_ = 0, k0B = 0, n0B = 0, modeB = 0;
#define CV_DECODE(it_, src, dst, K, N, k0, n0, mode) do { int r = (it_); \
        if (r < 2 * CI_ATT) { const int i = r / CI_ATT; int q = r % CI_ATT; bf16_t* base = (bf16_t*)(p.ws + WS_WATT + (size_t)i * 5 * MiB); \
            if (q < CI_QKV) { src = p.attn_w_qkv + (size_t)i * DM * QKVD; dst = base; K = DM; N = QKVD; k0 = (q / 6) * 64; n0 = (q % 6) * 256; mode = 4; } \
            else { q -= CI_QKV; src = p.attn_w_o + (size_t)i * DM * DM; dst = base + 3 * MiB / 2; K = DM; N = DM; k0 = (q / 4) * 64; n0 = (q % 4) * 256; mode = 4; } } \
        else if ((r -= 2 * CI_ATT) < 2 * CI_SSM) { const int i = r / CI_SSM; int q = r % CI_SSM; bf16_t* base = (bf16_t*)(p.ws + WS_WSSM + (size_t)i * 6 * MiB); \
            if (q < CI_SQ) { src = p.ssm_w_in + (size_t)i * DM * DM; dst = base; K = DM; N = DM; k0 = (q / 4) * 64; n0 = (q % 4) * 256; mode = 4; } \
            else { q -= CI_SQ; src = p.ssm_w_glu + (size_t)i * DM * 2 * DM; dst = base + 2 * MiB / 2; K = DM; N = 2 * DM; k0 = (q / 8) * 64; n0 = (q % 8) * 256; mode = 1; } } \
        else { r -= 2 * CI_SSM; const int lay_ = r / (NE * CI_EXP), v_ = r % (NE * CI_EXP);     \
            const int le = lay_ * NE + (v_ < NE * 32 ? v_ / 32 : (v_ - NE * 32) / 16), q = (v_ < NE * 32) ? (v_ % 32) : 32 + ((v_ - NE * 32) % 16), which = q >> 4, sub = q & 15; bf16_t* base = (bf16_t*)(p.ws + WS_WMOE + (size_t)le * 3 * MiB / 2); \
            if (which < 2) { src = (which ? p.moe_w_up : p.moe_w_gate) + (size_t)le * DM * FE; dst = base; K = DM; N = FE; k0 = sub * 64; n0 = 0; mode = 2 + which; } \
            else { src = p.moe_w_down + (size_t)le * FE * DM; dst = base + MiB / 2; K = FE; N = DM; k0 = (sub >> 2) * 64; n0 = (sub & 3) * 256; mode = 5; } } } while (0)
#define CV_LOAD(pre, src, N, k0, n0) do { _Pragma("unroll") for (int i_ = 0; i_ < 8; ++i_) { const int idx = tid_ + 512 * i_; pre[i_] = *(const f32x4*)(src + (size_t)(k0 + (idx >> 6)) * N + n0 + 4 * (idx & 63)); } } while (0)
#define CV_ITEM(pre, src, dst, K, N, k0, n0, mode, bufi, nxt_) do { \
        LAS float* Lt = (LAS float*)(cx.lds + (bufi) * 66560); \
        _Pragma("unroll") for (int i_ = 0; i_ < 8; ++i_) { const int idx = tid_ + 512 * i_; *(LAS f32x4*)(Lt + (idx >> 6) * 260 + 4 * (idx & 63)) = pre[i_]; } \
        bf16_t* cdst = dst; const int cK = K, ck0 = k0, cn0 = n0, cmode = mode; \
        __syncthreads(); \
        if ((nxt_) < cend) { CV_DECODE((nxt_), src, dst, K, N, k0, n0, mode); CV_LOAD(pre, src, N, k0, n0); } \
        _Pragma("unroll") for (int j_ = 0; j_ < 4; ++j_) { \
            const int id = tid_ + 512 * j_, n = id & 255, kc = id >> 8, ng = cn0 + n; \
            int drow = ng; \
            if (cmode == 1) drow = (ng < 1024) ? (256 * (ng >> 7) + (ng & 127)) : (256 * ((ng - 1024) >> 7) + 128 + (ng & 127));     \
            if (cmode == 2 || cmode == 3) drow = 256 * (ng >> 7) + (cmode == 3 ? 128 : 0) + (ng & 127);                               \
            const LAS float* lp = Lt + (8 * kc) * 260 + n; \
            if (cmode >= 1) {     \
                u32x2 o8; o8.x = pack4_fp8_raw(lp[0] * 16.f, lp[260] * 16.f, lp[2 * 260] * 16.f, lp[3 * 260] * 16.f); o8.y = pack4_fp8_raw(lp[4 * 260] * 16.f, lp[5 * 260] * 16.f, lp[6 * 260] * 16.f, lp[7 * 260] * 16.f); \
                *(u32x2*)((unsigned char*)cdst + (size_t)drow * cK + ck0 + 8 * kc) = o8; \
            } else { \
                u32x4 o; o.x = cvt_pk_bf16(lp[0], lp[260]); o.y = cvt_pk_bf16(lp[2 * 260], lp[3 * 260]); o.z = cvt_pk_bf16(lp[4 * 260], lp[5 * 260]); o.w = cvt_pk_bf16(lp[6 * 260], lp[7 * 260]); \
                *(u32x4*)(cdst + (size_t)drow * cK + ck0 + 8 * kc) = o; \
            } } } while (0)
    if (cbeg < cend) { CV_DECODE(cbeg, srcA, dstA, KA, NA, k0A, n0A, modeA); CV_LOAD(preA, srcA, NA, k0A, n0A); }
    if (cbeg + 1 < cend) { CV_DECODE(cbeg + 1, srcB, dstB, KB, NB_, k0B, n0B, modeB); CV_LOAD(preB, srcB, NB_, k0B, n0B); }
    for (int it = cbeg; it < cend; it += 2) {
        CV_ITEM(preA, srcA, dstA, KA, NA, k0A, n0A, modeA, 0, it + 2);
        if (it + 1 < cend) CV_ITEM(preB, srcB, dstB, KB, NB_, k0B, n0B, modeB, 1, it + 3);
    }
    __syncthreads();
#undef CV_DECODE
#undef CV_LOAD
#undef CV_ITEM
}

__device__ __forceinline__ void phase_p0(const Params& p, const Ctx& cx) {
    const int lane_ = opaque_v(lane_id()), tid_ = cx.wave * 64 + lane_;
    LAS float* cact = (LAS float*)(cx.lds + 69632);
#pragma unroll 8
    for (int idx = tid_; idx < NB * DM; idx += NWAVES * 64) { const int b = idx >> 10, k = idx & 1023; const float v = p.c[idx]; cact[k * 16 + b] = v * sigmoidf_(v); }
    __syncthreads();
    {
        LAS float* pw = (LAS float*)cx.lds;
        LAS float* Bb = pw + 17 * 64 * 2;
        LAS float* Cm = Bb + 64 * 16 * 2;
        LAS float* Km = Cm + 16 * 64 * 2;
        LAS float* dv = Km + 16 * 16 * 16;
        for (int it = cx.vcu; it < 2 * SG; it += cx.G) {
            const int si = it >> 6, g = it & 63;
            if (tid_ < 64) {
                const int gi = (si * 64 + g) * 64 + tid_;
                const float dt = expf(p.ssm_log_dt[si * 64 + g]);
                const float lr = p.ssm_lam_re[gi], li = p.ssm_lam_im[gi];
                const float mag = expf(lr * dt); float sn, cs; sincosf(li * dt, &sn, &cs);
                const float ab_re = mag * cs, ab_im = mag * sn;
                const float den = lr * lr + li * li, n_re = ab_re - 1.0f;
                const float f_re = (n_re * lr + ab_im * li) / den, f_im = (ab_im * lr - n_re * li) / den;
                float pr = 1.0f, pi = 0.0f;
                for (int j = 0; j <= 16; ++j) { pw[(j * 64 + tid_) * 2] = pr; pw[(j * 64 + tid_) * 2 + 1] = pi; const float nr = pr * ab_re - pi * ab_im, ni = pr * ab_im + pi * ab_re; pr = nr; pi = ni; }
                for (int c = 0; c < 16; ++c) { const float br = p.ssm_b_re[(size_t)gi * 16 + c], bi = p.ssm_b_im[(size_t)gi * 16 + c];
                    Bb[(tid_ * 16 + c) * 2] = f_re * br - f_im * bi; Bb[(tid_ * 16 + c) * 2 + 1] = f_re * bi + f_im * br; }
            }
            for (int e = tid_; e < 1024; e += NWAVES * 64) { Cm[e * 2] = p.ssm_c_re[(size_t)(si * 64 + g) * 1024 + e]; Cm[e * 2 + 1] = p.ssm_c_im[(size_t)(si * 64 + g) * 1024 + e]; }
            if (tid_ < 16) dv[tid_] = p.ssm_d[si * DM + g * 16 + tid_];
            __syncthreads();
            {
                const int j = tid_ >> 5, co = (tid_ >> 1) & 15, ch = tid_ & 1;
                float a[8];
#pragma unroll
                for (int q = 0; q < 8; ++q) a[q] = 0.f;
                for (int pp = 0; pp < 64; ++pp) {
                    const f32x2 cc = *(const LAS f32x2*)(Cm + (co * 64 + pp) * 2), ww = *(const LAS f32x2*)(pw + (j * 64 + pp) * 2);
                    const float zr = cc[0] * ww[0] - cc[1] * ww[1], zi = cc[0] * ww[1] + cc[1] * ww[0];
                    const LAS f32x4* bp = (const LAS f32x4*)(Bb + (pp * 16 + 8 * ch) * 2);
                    const f32x4 b0 = bp[0], b1 = bp[1], b2 = bp[2], b3 = bp[3];
                    a[0] += zr * b0[0] - zi * b0[1]; a[1] += zr * b0[2] - zi * b0[3]; a[2] += zr * b1[0] - zi * b1[1]; a[3] += zr * b1[2] - zi * b1[3];
                    a[4] += zr * b2[0] - zi * b2[1]; a[5] += zr * b2[2] - zi * b2[3]; a[6] += zr * b3[0] - zi * b3[1]; a[7] += zr * b3[2] - zi * b3[3];
                }
#pragma unroll
                for (int q = 0; q < 8; ++q) Km[(j * 16 + co) * 16 + 8 * ch + q] = a[q];
            }
            __syncthreads();
            bf16_t* TH = (bf16_t*)(p.ws + WS_SSMM + (size_t)si * 20 * MiB) + (size_t)g * 256 * 384;
            bf16_t* Gm = (bf16_t*)(p.ws + WS_SSMM + (size_t)si * 20 * MiB + 12 * MiB) + (size_t)g * 256 * 256;
            for (int ch = tid_; ch < 256 * 48; ch += NWAVES * 64) {
                const int n = ch / 48, kk0 = (ch % 48) * 8, t = n >> 4, co = n & 15; float v[8];
                if (kk0 < 256) {
                    const int s_ = kk0 >> 4, ci0 = kk0 & 15;
                    if (s_ <= t) { const LAS f32x4* kp = (const LAS f32x4*)(Km + ((t - s_) * 16 + co) * 16 + ci0); const f32x4 k0 = kp[0], k1 = kp[1];
#pragma unroll
                        for (int q = 0; q < 4; ++q) { v[q] = k0[q]; v[4 + q] = k1[q]; }
                        if (s_ == t && (co >> 3) == (ci0 >> 3)) { const float d_ = dv[co];
#pragma unroll
                            for (int q = 0; q < 8; ++q) v[q] += ((co & 7) == q) ? d_ : 0.f; } }
                    else {
#pragma unroll
                        for (int q = 0; q < 8; ++q) v[q] = 0.f; }
                } else {
                    const int pp0 = (kk0 - 256) >> 1;
                    const LAS f32x4* cp = (const LAS f32x4*)(Cm + (co * 64 + pp0) * 2); const LAS f32x4* wp4 = (const LAS f32x4*)(pw + ((t + 1) * 64 + pp0) * 2);
                    const f32x4 c0 = cp[0], c1 = cp[1], w0 = wp4[0], w1 = wp4[1];
                    v[0] = c0[0] * w0[0] - c0[1] * w0[1]; v[1] = -(c0[0] * w0[1] + c0[1] * w0[0]); v[2] = c0[2] * w0[2] - c0[3] * w0[3]; v[3] = -(c0[2] * w0[3] + c0[3] * w0[2]);
                    v[4] = c1[0] * w1[0] - c1[1] * w1[1]; v[5] = -(c1[0] * w1[1] + c1[1] * w1[0]); v[6] = c1[2] * w1[2] - c1[3] * w1[3]; v[7] = -(c1[2] * w1[3] + c1[3] * w1[2]);
                }
                u32x4 o; o.x = cvt_pk_bf16(v[0], v[1]); o.y = cvt_pk_bf16(v[2], v[3]); o.z = cvt_pk_bf16(v[4], v[5]); o.w = cvt_pk_bf16(v[6], v[7]);
                *(u32x4*)(TH + (size_t)n * 384 + kk0) = o;
            }
            for (int ch = tid_; ch < 256 * 32; ch += NWAVES * 64) {
                const int n = ch >> 5, kk0 = (ch & 31) * 8; float v[8];
                if (n < 128) { const int pp = n >> 1, im = n & 1, s_ = kk0 >> 4, ci0 = kk0 & 15;
                    const float wr_ = pw[((15 - s_) * 64 + pp) * 2], wi_ = pw[((15 - s_) * 64 + pp) * 2 + 1];
                    const LAS f32x4* bp = (const LAS f32x4*)(Bb + (pp * 16 + ci0) * 2); const f32x4 b0 = bp[0], b1 = bp[1], b2 = bp[2], b3 = bp[3];
                    const float br[8] = {b0[0], b0[2], b1[0], b1[2], b2[0], b2[2], b3[0], b3[2]}, bi[8] = {b0[1], b0[3], b1[1], b1[3], b2[1], b2[3], b3[1], b3[3]};
#pragma unroll
                    for (int q = 0; q < 8; ++q) v[q] = im ? (wr_ * bi[q] + wi_ * br[q]) : (wr_ * br[q] - wi_ * bi[q]); }
                else {
#pragma unroll
                    for (int q = 0; q < 8; ++q) v[q] = 0.f; }
                u32x4 o; o.x = cvt_pk_bf16(v[0], v[1]); o.y = cvt_pk_bf16(v[2], v[3]); o.z = cvt_pk_bf16(v[4], v[5]); o.w = cvt_pk_bf16(v[6], v[7]);
                *(u32x4*)(Gm + (size_t)n * 256 + kk0) = o;
            }
            __syncthreads();
        }
    }
    float* ada = (float*)(p.ws + WS_ADA);
    float* abar = (float*)(p.ws + WS_SSMP);
    constexpr int N_ADA_IT = 4 * 384, N_SSM_IT = 2 * 64;
    constexpr int N_ITEMS = N_ADA_IT + N_SSM_IT;
    for (int it = cx.gw; it < N_ITEMS; it += cx.NGW) {
        if (it < N_ADA_IT) {
            const int l = it / 384, nb = it % 384, n16 = lane_ & 15, kq = lane_ >> 4, col = nb * 16 + n16;
            const float* W = p.w_ada + (size_t)l * DM * ADA + (size_t)kq * ADA + col;
            const LAS float* ca = cact + kq * 16 + n16;
            f32x4 acc[4];
#pragma unroll
            for (int q = 0; q < 4; ++q) acc[q] = (f32x4){0.f, 0.f, 0.f, 0.f};
#pragma unroll 1
            for (int k0 = 0; k0 < DM; k0 += 256) {
                float w[64];
#pragma unroll
                for (int q = 0; q < 64; ++q) w[q] = W[(size_t)(k0 + 4 * q) * ADA];
#pragma unroll
                for (int q = 0; q < 64; ++q) acc[q & 3] = __builtin_amdgcn_mfma_f32_16x16x4f32(ca[(k0 + 4 * q) * 16], w[q], acc[q & 3], 0, 0, 0);
            }
            const f32x4 o = (acc[0] + acc[1]) + (acc[2] + acc[3]);
            const float bias = p.b_ada[l * ADA + col];
#pragma unroll
            for (int r4 = 0; r4 < 4; ++r4) ada[(size_t)(l * 16 + 4 * kq + r4) * ADA + col] = o[r4] + bias;
            continue;
        }
        int r = it - N_ADA_IT;
        if (r < N_SSM_IT) {
            const int si = r >> 6, g = r & 63, pp = lane_, gi = (si * 64 + g) * 64 + pp;
            const float dt = expf(p.ssm_log_dt[si * 64 + g]);
            const float lr = p.ssm_lam_re[gi], li = p.ssm_lam_im[gi];
            const float mag = expf(lr * dt); float sn, cs; sincosf(li * dt, &sn, &cs);
            const float ab_re = mag * cs, ab_im = mag * sn;
            const float den = lr * lr + li * li, n_re = ab_re - 1.0f;
            const float f_re = (n_re * lr + ab_im * li) / den, f_im = (ab_im * lr - n_re * li) / den;
            abar[gi * 2 + 0] = ab_re; abar[gi * 2 + 1] = ab_im;
            continue;
        }
    }
    __syncthreads();
    {
        constexpr int NCI = CONV_IN_TAIL ? CI_DENSE + NE * 32 : CI_DENSE + DEPTH * NE * CI_EXP;
        constexpr int CH = 2, NCH = (NCI + CH - 1) / CH;
        unsigned* ctr = (unsigned*)(p.ws + WS_CTL) + CW_CONV + 7 * 64;
        volatile LAS unsigned* slot = (volatile LAS unsigned*)(cx.lds + MISC_OFF) + 100;
        if (tid_ == 0) *slot = __hip_atomic_fetch_add(ctr, 1u, __ATOMIC_RELAXED, __HIP_MEMORY_SCOPE_AGENT);
        __syncthreads();
        unsigned cur = *slot;
        while (cur < (unsigned)NCH) {
            unsigned nxt = 0;
            if (tid_ == 0) nxt = __hip_atomic_fetch_add(ctr, 1u, __ATOMIC_RELAXED, __HIP_MEMORY_SCOPE_AGENT);
            { const int cbeg = (int)cur * CH; int cend = cbeg + CH; if (cend > NCI) cend = NCI; conv_range(p, cx, tid_, cbeg, cend); }
            if (tid_ == 0) *slot = nxt;
            __syncthreads();
            cur = *slot;
        }
    }
}

__device__ __forceinline__ void n1_build_operator(const Params& p, const Ctx& cx, int l, const int lane_) {
    const float* ada = (const float*)(p.ws + WS_ADA);
        const float* We = p.moe_w_expert + (size_t)l * DM * NE; const float* Wg = p.moe_w_group + (size_t)l * DM * 4; const float* gn = p.norm_ffn + l * DM;
        unsigned char* WR = p.ws + WS_WR; float* WRC = (float*)(p.ws + WS_WR + 16 * 147456);
        for (int it = cx.gw * 64 + lane_; it < 16 * 36 * 128; it += cx.NGW * 64) {
            const int b = it / 4608, rem = it % 4608, chunk = rem / 36, j = rem % 36, k0 = chunk * 8; float w[8];
            const float* sc2 = ada + (size_t)(l * 16 + b) * ADA + 4096;
#pragma unroll
            for (int q = 0; q < 8; ++q) { const int k = k0 + q; const float wv = (j < 32) ? We[k * NE + j] : Wg[k * 4 + (j - 32)]; w[q] = wv * gn[k] * (1.0f + sc2[k]); }
            u32x4 hi, lo;
            hi.x = cvt_pk_bf16(w[0], w[1]); hi.y = cvt_pk_bf16(w[2], w[3]); hi.z = cvt_pk_bf16(w[4], w[5]); hi.w = cvt_pk_bf16(w[6], w[7]);
            lo.x = cvt_pk_bf16(w[0] - bf_lo(hi.x), w[1] - bf_hi(hi.x)); lo.y = cvt_pk_bf16(w[2] - bf_lo(hi.y), w[3] - bf_hi(hi.y));
            lo.z = cvt_pk_bf16(w[4] - bf_lo(hi.z), w[5] - bf_hi(hi.z)); lo.w = cvt_pk_bf16(w[6] - bf_lo(hi.w), w[7] - bf_hi(hi.w));
            const unsigned off = (unsigned)(j * 2048 + ((chunk & ~15) | ((chunk ^ j) & 15)) * 16);
            *(u32x4*)(WR + (size_t)b * 147456 + off) = hi; *(u32x4*)(WR + (size_t)b * 147456 + 73728 + off) = lo;
        }
        for (int it = cx.gw; it < 16 * 36; it += cx.NGW) {
            const int b = it / 36, j = it % 36; const float* sh2 = ada + (size_t)(l * 16 + b) * ADA + 3072; float a = 0.f;
#pragma unroll
            for (int q = 0; q < 16; ++q) { const int k = lane_ + 64 * q; a += sh2[k] * ((j < 32) ? We[k * NE + j] : Wg[k * 4 + (j - 32)]); }
            a = wave_sum(a);
            if (lane_ == 0) WRC[b * 48 + j] = a + ((j < 32) ? p.moe_b_expert[l * NE + j] : p.moe_b_group[l * 4 + j - 32]);
        }
}

template <int MODE>
__device__ __forceinline__ void phase_n1(const Params& p, const Ctx& cx, int l, const float* g2l) {
    const int lane_ = opaque_v(lane_id()), tid_ = cx.wave * 64 + lane_;
    const float* ada = (const float*)(p.ws + WS_ADA);
    const unsigned char* Y8 = (const unsigned char*)(p.ws + WS_R + R_Y);
    bf16_t* H = (bf16_t*)((char*)p.out + OUT_H);
    bf16_t* XB = (bf16_t*)(p.ws + WS_XB); const bf16_t* DL = (const bf16_t*)(p.ws + WS_D);
    bool op_pending = (MODE != 2);
    for (int rb = cx.gw; rb < NTOK / 16; rb += cx.NGW) {
        const int row0 = rb * 16, b = row0 >> 11;
        f32x4 A[2][2], Bv[2][2], G2[2][2];
#pragma unroll
        for (int j = 0; j < 2; ++j)
#pragma unroll
            for (int q = 0; q < 2; ++q) { const int col = 8 * lane_ + 512 * j + 4 * q;
                if (MODE != 2) { const f32x4 gain = *(const f32x4*)(p.norm_mix + l * DM + col); const f32x4 sc = *(const f32x4*)(ada + (size_t)(l * 16 + b) * ADA + 1024 + col);
                    A[j][q] = gain * (sc + 1.0f); Bv[j][q] = *(const f32x4*)(ada + (size_t)(l * 16 + b) * ADA + col); }
                if (MODE != 0) G2[j][q] = *(const f32x4*)(g2l + (size_t)b * ADA + col); }
        f32x4 Ax[2][2][2], Bx[2][2][2]; u32x4 Axb[2][2], Adl[2][2], Bxb[2][2], Bdl[2][2]; u32x2 Ay0[2][2], Ay1[2][2], By0[2][2], By1[2][2];
#define N1_LOAD(S_, r_) do { _Pragma("unroll") for (int rr = 0; rr < 2; ++rr) { const size_t row = (size_t)(row0 + (r_) + rr); \
            _Pragma("unroll") for (int j = 0; j < 2; ++j) { const int col = 8 * lane_ + 512 * j; \
                if (MODE == 0) { S_##x[rr][j][0] = *(const f32x4*)(p.x + row * DM + col); S_##x[rr][j][1] = *(const f32x4*)(p.x + row * DM + col + 4); } \
                else { S_##xb[rr][j] = *(const u32x4*)(XB + row * DM + col); S_##dl[rr][j] = *(const u32x4*)(DL + row * DM + col); \
                    S_##y0[rr][j] = *(const u32x2*)(Y8 + row * DM + col); S_##y1[rr][j] = *(const u32x2*)(Y8 + ((size_t)NTOK + row) * DM + col); } } } } while (0)
#define N1_PROC(S_, r_) do { f32x4 v[2][2][2]; float ss[2];     \
            _Pragma("unroll") for (int rr = 0; rr < 2; ++rr) { const size_t row = (size_t)(row0 + (r_) + rr); ss[rr] = 0.f; \
                _Pragma("unroll") for (int j = 0; j < 2; ++j) { const int col = 8 * lane_ + 512 * j; \
                    if (MODE == 0) { v[rr][j][0] = S_##x[rr][j][0]; v[rr][j][1] = S_##x[rr][j][1]; } \
                    else {     \
                        const u32x4 xb = S_##xb[rr][j], dl = S_##dl[rr][j]; const u32x2 y0 = S_##y0[rr][j], y1 = S_##y1[rr][j]; \
                        const f32x4 ys0 = unpack4_fp8(y0.x) + unpack4_fp8(y1.x), ys1 = unpack4_fp8(y0.y) + unpack4_fp8(y1.y); \
                        f32x4 x0, x1; \
                        x0[0] = bf_lo(xb.x) + bf_lo(dl.x); x0[1] = bf_hi(xb.x) + bf_hi(dl.x); x0[2] = bf_lo(xb.y) + bf_lo(dl.y); x0[3] = bf_hi(xb.y) + bf_hi(dl.y); \
                        x1[0] = bf_lo(xb.z) + bf_lo(dl.z); x1[1] = bf_hi(xb.z) + bf_hi(dl.z); x1[2] = bf_lo(xb.w) + bf_lo(dl.w); x1[3] = bf_hi(xb.w) + bf_hi(dl.w); \
                        v[rr][j][0] = x0 + G2[j][0] * ys0; v[rr][j][1] = x1 + G2[j][1] * ys1; } \
                    const f32x4 a0 = v[rr][j][0], a1 = v[rr][j][1]; \
                    if (MODE == 2) { *(f32x4*)(p.out + row * DM + col) = a0; *(f32x4*)(p.out + row * DM + col + 4) = a1; } \
                    else { u32x4 w; w.x = cvt_pk_bf16(a0[0], a0[1]); w.y = cvt_pk_bf16(a0[2], a0[3]); w.z = cvt_pk_bf16(a1[0], a1[1]); w.w = cvt_pk_bf16(a1[2], a1[3]); *(u32x4*)(XB + row * DM + col) = w; } \
                    ss[rr] += ((a0[0] * a0[0] + a0[1] * a0[1]) + (a0[2] * a0[2] + a0[3] * a0[3])) + ((a1[0] * a1[0] + a1[1] * a1[1]) + (a1[2] * a1[2] + a1[3] * a1[3])); } } \
            if (MODE != 2) { \
                _Pragma("unroll") for (int rr = 0; rr < 2; ++rr) ss[rr] = wave_sum(ss[rr]); \
                _Pragma("unroll") for (int rr = 0; rr < 2; ++rr) { const size_t row = (size_t)(row0 + (r_) + rr); \
                    const float rstd = rsqrtf(ss[rr] * (1.0f / DM) + RMS_EPS); \
                    _Pragma("unroll") for (int j = 0; j < 2; ++j) { const int col = 8 * lane_ + 512 * j; const f32x4 h0 = v[rr][j][0] * rstd * A[j][0] + Bv[j][0], h1 = v[rr][j][1] * rstd * A[j][1] + Bv[j][1]; \
                        { u32x2 w8; w8.x = pack4_fp8_raw(h0[0], h0[1], h0[2], h0[3]); w8.y = pack4_fp8_raw(h1[0], h1[1], h1[2], h1[3]); *(u32x2*)((unsigned char*)H + row * DM + col) = w8; } } } } } while (0)
        N1_LOAD(A, 0);
        if (op_pending) { n1_build_operator(p, cx, l, lane_); op_pending = false; }
#pragma unroll 1
        for (int r = 0; r < 16; r += 4) {
            N1_LOAD(B, r + 2);
            N1_PROC(A, r);
            if (r + 4 < 16) N1_LOAD(A, r + 4);
            N1_PROC(B, r + 2);
        }
#undef N1_LOAD
#undef N1_PROC
    }
    if (op_pending) n1_build_operator(p, cx, l, lane_);
}

typedef float f32x4v __attribute__((ext_vector_type(4)));
__device__ __forceinline__ unsigned n2_wslot(int j, int chunk) { return (unsigned)(j * 2048 + ((chunk & ~15) | ((chunk ^ j) & 15)) * 16); }
__device__ __forceinline__ void phase_n2(const Params& p, const Ctx& cx, int l, int cl) {
    const int lane_ = opaque_v(lane_id()), tid_ = cx.wave * 64 + lane_;
    const float* ada = (const float*)(p.ws + WS_ADA);
    unsigned char* H8 = (unsigned char*)p.out + OUT_H;
    const bf16_t* XB = (const bf16_t*)(p.ws + WS_XB); const bf16_t* DL = (const bf16_t*)(p.ws + WS_D);
    LAS unsigned char* Whi = cx.lds;
    LAS unsigned char* Wlo = cx.lds + 73728;
    LAS float* LG = (LAS float*)cx.lds;
    LAS int* cnt = (LAS int*)(cx.lds + N2_TAB);
    LAS int* basev = cnt + 32;
    LAS int* ri_e = cnt + 64;
    LAS int* ri_s = cnt + 64 + 256;
    LAS float* ri_g = (LAS float*)(cnt + 64 + 512);
    LAS float* rs = (LAS float*)(cnt + 64 + 768);
    LAS float* cb = rs + 128;
    unsigned* gcnt = (unsigned*)(p.ws + WS_CTL) + CW_GCNT + cl * 32 * 64;
    u32x2* list = (u32x2*)(p.ws + WS_LIST);
    const float* We = p.moe_w_expert + (size_t)l * DM * NE; const float* Wg = p.moe_w_group + (size_t)l * DM * 4;
    for (int rb = cx.vcu; rb < NTOK / 128; rb += cx.G) {
        const int wrow0 = rb * 128 + cx.wave * 16, b = wrow0 >> 11;
        const float* sc2 = ada + (size_t)(l * 16 + b) * ADA + 4096; const float* sh2 = ada + (size_t)(l * 16 + b) * ADA + 3072; const float* gn = p.norm_ffn + l * DM;
        if (tid_ < 32) cnt[tid_] = 0;
        const int c16 = lane_ & 15, fq = lane_ >> 4;
        const unsigned voff = (unsigned)(((wrow0 + c16) * DM + 16 * fq) * 2);
        const char* xr = (const char*)XB; const char* dr = (const char*)DL;
        u32x4 xq[16][2], dq[16][2], x2p[16][2];
#define N2_LD(S_) do { xq[S_][0] = *(const u32x4*)(xr + (voff + 128u * (S_))); xq[S_][1] = *(const u32x4*)(xr + (voff + 128u * (S_) + 16u)); dq[S_][0] = *(const u32x4*)(dr + (voff + 128u * (S_))); dq[S_][1] = *(const u32x4*)(dr + (voff + 128u * (S_) + 16u)); } while (0)
        N2_LD(0); N2_LD(1);
        {
            const u32x4* src = (const u32x4*)(p.ws + WS_WR + (size_t)b * 147456);
#pragma unroll
            for (int q = 0; q < 18; ++q) { const int i = tid_ + q * (NWAVES * 64); ((LAS u32x4*)cx.lds)[i] = src[i]; }
            if (tid_ < 36) cb[tid_] = ((const float*)(p.ws + WS_WR + 16 * 147456))[b * 48 + tid_];
            LAS float* AB = (LAS float*)(cx.lds + N2_AB);
#pragma unroll
            for (int q = 0; q < 2; ++q) { const int k = tid_ + 512 * q; AB[k] = gn[k] * (1.0f + sc2[k]); AB[1024 + k] = sh2[k]; }
        }
        __syncthreads();
        f32x4v acc[3];
#pragma unroll
        for (int t = 0; t < 3; ++t) acc[t] = (f32x4v){0.f, 0.f, 0.f, 0.f};
        float ssq = 0.f;
        {
            const int j2 = (32 + c16) < 36 ? (32 + c16) : 35;
            int wb[3];
#pragma unroll
            for (int t = 0; t < 3; ++t) { const int j = (t == 2) ? j2 : 16 * t + c16; wb[t] = j * 2048 + 16 * (((2 * fq) ^ j) & 15); }
#pragma unroll
            for (int S = 0; S < 16; ++S) {
                __builtin_amdgcn_sched_barrier(0);
                if (S + 2 < 16) N2_LD(S + 2);
                __builtin_amdgcn_sched_barrier(0);
#pragma unroll
                for (int u = 0; u < 2; ++u) {
                    bf16x8 wh[3], wl[3];
#pragma unroll
                    for (int t = 0; t < 3; ++t) { const int a = opaque_v(wb[t]) ^ (16 * (u | 8 * (S & 1)));
                        wh[t] = *(const LAS bf16x8*)(Whi + a + 256 * (S >> 1)); wl[t] = *(const LAS bf16x8*)(Whi + (a + 73728) + 256 * (S >> 1)); }
                    const u32x4 xw = xq[S][u], dw = dq[S][u];
                    const bf16x8 xa = __builtin_bit_cast(bf16x8, xw), da = __builtin_bit_cast(bf16x8, dw);
#pragma unroll
                    for (int t = 0; t < 3; ++t) acc[t] = __builtin_amdgcn_mfma_f32_16x16x32_bf16(xa, wh[t], acc[t], 0, 0, 0);
#pragma unroll
                    for (int t = 0; t < 3; ++t) acc[t] = __builtin_amdgcn_mfma_f32_16x16x32_bf16(da, wh[t], acc[t], 0, 0, 0);
#pragma unroll
                    for (int t = 0; t < 3; ++t) acc[t] = __builtin_amdgcn_mfma_f32_16x16x32_bf16(xa, wl[t], acc[t], 0, 0, 0);
#pragma unroll
                    for (int t = 0; t < 3; ++t) acc[t] = __builtin_amdgcn_mfma_f32_16x16x32_bf16(da, wl[t], acc[t], 0, 0, 0);
                    f32x4 v0, v1;
                    v0[0] = bf_lo(xw.x) + bf_lo(dw.x); v0[1] = bf_hi(xw.x) + bf_hi(dw.x); v0[2] = bf_lo(xw.y) + bf_lo(dw.y); v0[3] = bf_hi(xw.y) + bf_hi(dw.y);
                    v1[0] = bf_lo(xw.z) + bf_lo(dw.z); v1[1] = bf_hi(xw.z) + bf_hi(dw.z); v1[2] = bf_lo(xw.w) + bf_lo(dw.w); v1[3] = bf_hi(xw.w) + bf_hi(dw.w);
                    ssq += ((v0[0] * v0[0] + v0[1] * v0[1]) + (v0[2] * v0[2] + v0[3] * v0[3])) + ((v1[0] * v1[0] + v1[1] * v1[1]) + (v1[2] * v1[2] + v1[3] * v1[3]));
                    u32x4 pk; pk.x = cvt_pk_bf16(v0[0], v0[1]); pk.y = cvt_pk_bf16(v0[2], v0[3]); pk.z = cvt_pk_bf16(v1[0], v1[1]); pk.w = cvt_pk_bf16(v1[2], v1[3]);
                    x2p[S][u] = pk;
                }
            }
        }
#undef N2_LD
        float rstd;
        {
            ssq += xor_swz<16>(ssq); ssq = half_sum(ssq);
            rstd = rsqrtf(ssq * (1.0f / DM) + RMS_EPS);
            const int lane3 = opaque_v(lane_id()); if ((lane3 >> 4) == 0) rs[cx.wave * 16 + (lane3 & 15)] = rstd;
        }
        __syncthreads();
        const int lane2 = opaque_v(lane_id()), tid2 = cx.wave * 64 + lane2, c16b = lane2 & 15, fqb = lane2 >> 4;
        {
            LAS float* lgw = LG + cx.wave * (16 * 48);
#pragma unroll
            for (int t = 0; t < 3; ++t)
#pragma unroll
                for (int i = 0; i < 4; ++i) { const int rho = 4 * fqb + i, col = 16 * t + c16b; if (col < 36) lgw[rho * 48 + col] = acc[t][i] * rs[cx.wave * 16 + rho] + cb[col]; }
            asm volatile("s_waitcnt lgkmcnt(0)" ::: "memory");
            if (lane2 < 16) {
                const LAS float* lr = lgw + lane2 * 48;
                int gi = 0; float gm = lr[32];
#pragma unroll
                for (int i = 1; i < 4; ++i) { const float v = lr[32 + i]; if (v > gm) { gm = v; gi = i; } }
                float gden = 0.f;
#pragma unroll
                for (int i = 0; i < 4; ++i) gden += __expf(lr[32 + i] - gm);
                const float gwt = 1.0f / gden;
                float l1 = -3.0e38f, l2 = -3.0e38f; int i1 = 0, i2 = 0;
#pragma unroll
                for (int i = 0; i < 8; ++i) { const float ev = lr[gi * 8 + i];
                    if (ev > l1) { l2 = l1; i2 = i1; l1 = ev; i1 = i; } else if (ev > l2) { l2 = ev; i2 = i; } }
                const float tt = __expf(l2 - l1), p1 = 1.0f / (1.0f + tt), p2 = tt * p1;
                const int rloc = cx.wave * 16 + lane2, e1 = gi * 8 + i1, e2 = gi * 8 + i2;
                const int s1 = __hip_atomic_fetch_add(cnt + e1, 1, __ATOMIC_RELAXED, __HIP_MEMORY_SCOPE_WORKGROUP);
                const int s2 = __hip_atomic_fetch_add(cnt + e2, 1, __ATOMIC_RELAXED, __HIP_MEMORY_SCOPE_WORKGROUP);
                ri_e[rloc * 2] = e1; ri_e[rloc * 2 + 1] = e2; ri_s[rloc * 2] = s1; ri_s[rloc * 2 + 1] = s2; ri_g[rloc * 2] = gwt * p1; ri_g[rloc * 2 + 1] = gwt * p2;
            }
        }
        __syncthreads();
        int basev_r = 0;
        if (tid2 < 32) basev_r = (int)__hip_atomic_fetch_add(gcnt + tid2 * 64, (unsigned)cnt[tid2], __ATOMIC_RELAXED, __HIP_MEMORY_SCOPE_AGENT);
        {
            const int lane3 = opaque_v(lane_id()), c16c = lane3 & 15, fqc = lane3 >> 4;
            const LAS float* AB = (const LAS float*)(cx.lds + opaque_v(N2_AB + 64 * fqc));
            unsigned char* hrow = H8 + (size_t)(wrow0 + c16c) * DM + 16 * fqc;
#pragma unroll
            for (int S = 0; S < 16; ++S) {
                __builtin_amdgcn_sched_barrier(0);
                u32x4 w8;
#pragma unroll
                for (int u = 0; u < 2; ++u) {
                    const int k0 = 64 * S + 8 * u;
                    const f32x4 a0 = *(const LAS f32x4*)(AB + k0), a1 = *(const LAS f32x4*)(AB + k0 + 4), b0 = *(const LAS f32x4*)(AB + 1024 + k0), b1 = *(const LAS f32x4*)(AB + 1024 + k0 + 4);
                    const u32x4 pk = x2p[S][u];
                    const float h0 = bf_lo(pk.x) * (rstd * a0[0]) + b0[0], h1 = bf_hi(pk.x) * (rstd * a0[1]) + b0[1], h2_ = bf_lo(pk.y) * (rstd * a0[2]) + b0[2], h3 = bf_hi(pk.y) * (rstd * a0[3]) + b0[3];
                    const float h4 = bf_lo(pk.z) * (rstd * a1[0]) + b1[0], h5 = bf_hi(pk.z) * (rstd * a1[1]) + b1[1], h6 = bf_lo(pk.w) * (rstd * a1[2]) + b1[2], h7 = bf_hi(pk.w) * (rstd * a1[3]) + b1[3];
                    const unsigned lo_ = pack4_fp8_raw(h0, h1, h2_, h3), hi_ = pack4_fp8_raw(h4, h5, h6, h7);
                    if (u == 0) { w8.x = lo_; w8.y = hi_; } else { w8.z = lo_; w8.w = hi_; }
                }
                *(u32x4*)(hrow + 64 * S) = w8;
            }
                }
        if (tid2 < 32) basev[tid2] = basev_r;
        __syncthreads();
        if (tid2 < 256) { const int e = ri_e[tid2], slot = basev[e] + ri_s[tid2]; const unsigned tok = (unsigned)(rb * 128 + (tid2 >> 1));
            u32x2 ent; ent.x = tok * 2u + (unsigned)(tid2 & 1); ent.y = __float_as_uint(ri_g[tid2]); list[(size_t)e * NTOK + slot] = ent; }
        __syncthreads();
    }
}

template <int NCT, bool WITH_GATE>
__device__ __forceinline__ int moe_setup(const Params& p, const Ctx& cx, int l, int tail_ctr) {
    const int lane_ = opaque_v(lane_id()), tid_ = cx.wave * 64 + lane_;
    LAS int* utab = (LAS int*)(cx.lds + MOE_TAB);
    LAS int* nun = utab + MAXU * 8;
    LAS int* ecnt = (LAS int*)(cx.lds + N2_AB);
    unsigned* gcnt = (unsigned*)(p.ws + WS_CTL) + CW_GCNT + l * 32 * 64;
    const u32x2* list = (const u32x2*)(p.ws + WS_LIST);
    LAS int* toff = ecnt + 32;
    if (!WITH_GATE) {
        if (cx.wave == 0) {
            const int cnt_ = (lane_ < 32) ? (int)__hip_atomic_load(gcnt + lane_ * 64, __ATOMIC_RELAXED, __HIP_MEMORY_SCOPE_AGENT) : 0;
            const int ntl = (cnt_ + 255) >> 8; int exc = 0, tot = 0;
#pragma unroll
            for (int q = 0; q < 32; ++q) { const int v_ = __builtin_amdgcn_readlane(ntl, q); exc += (q < lane_) ? v_ : 0; tot += v_; }
            if (lane_ < 32) { ecnt[lane_] = cnt_; toff[lane_] = exc; if (lane_ == 31) toff[32] = tot; }
        }
        __syncthreads();
    }
    if (tid_ < MAXU) {
        const int T = toff[32], i = tid_;
        const int L = i * cx.G + cx.vcu, t = L / NCT, pn = L % NCT;
        int valid = (t < T) ? 1 : 0, e = 0;
        for (int q = 0; q < 32; ++q) e = (toff[q] <= t) ? q : e;
        const int tie = t - toff[e]; int rows = ecnt[e] - tie * 256; rows = rows > 256 ? 256 : rows;
        if (valid) { utab[i * 8 + 0] = t; utab[i * 8 + 1] = pn; utab[i * 8 + 2] = e; utab[i * 8 + 3] = rows; utab[i * 8 + 4] = tie; }
        const unsigned long long m = __ballot(valid != 0);
        if (tid_ == 0) { *nun = __popcll(m); nun[1] = T; }
    }
    __syncthreads();
    const int nu = *nun;
    unsigned tk = 0xffffffffu;
    if (tail_ctr >= 0 && tid_ == 0) {
        const int total = NCT * nun[1], rounds = (total + cx.G - 1) / cx.G; int n_late = total - (rounds - 1) * cx.G; if (n_late >= cx.G) n_late = 0;
        if (cx.vcu >= n_late) tk = __hip_atomic_fetch_add((unsigned*)(p.ws + WS_CTL) + CW_CONV + tail_ctr * 64, 1u, __ATOMIC_RELAXED, __HIP_MEMORY_SCOPE_AGENT);
    }
    {
        u32x2 ents[MAXU]; bool vals[MAXU];
#pragma unroll
        for (int i = 0; i < MAXU; ++i) {
            ents[i].x = 0xffffffffu; ents[i].y = 0u; vals[i] = false;
            if (i < nu && tid_ < 256) {
                const int e = utab[i * 8 + 2], rows = utab[i * 8 + 3], tie = utab[i * 8 + 4];
                vals[i] = tid_ < rows;
                if (vals[i]) ents[i] = list[(size_t)e * NTOK + tie * 256 + tid_];
            }
        }
#pragma unroll
        for (int i = 0; i < MAXU; ++i)
            if (i < nu && tid_ < 256) {
                if (WITH_GATE) ((LAS u32x2*)(cx.lds + MOE_TAB + 256))[i * 256 + tid_] = ents[i];
                else ((LAS unsigned*)(cx.lds + MOE_TAB + 256))[i * 256 + tid_] = vals[i] ? (ents[i].x >> 1) * (unsigned)DM : 0u;
            }
    }
    if (tid_ == 0) ((volatile LAS unsigned*)(cx.lds + MISC_OFF))[100] = tk;
    __syncthreads();
    return nu;
}

typedef float f32x16 __attribute__((ext_vector_type(16)));
__device__ __forceinline__ float half_max(float v) { const auto r = __builtin_amdgcn_permlane32_swap(__float_as_uint(v), __float_as_uint(v), false, false); return fmaxf(__uint_as_float(r[0]), __uint_as_float(r[1])); }
__device__ __forceinline__ float ssq8(const u32x4 w) { const float a0 = bf_lo(w.x), a1 = bf_hi(w.x), a2 = bf_lo(w.y), a3 = bf_hi(w.y), a4 = bf_lo(w.z), a5 = bf_hi(w.z), a6 = bf_lo(w.w), a7 = bf_hi(w.w);
    return (a0 * a0 + a1 * a1) + (a2 * a2 + a3 * a3) + (a4 * a4 + a5 * a5) + (a6 * a6 + a7 * a7); }
__device__ __forceinline__ void phase_attn(const Params& p, const Ctx& cx, int li, unsigned char* Odst) {
    const int lane_ = opaque_v(lane_id()), tid_ = cx.wave * 64 + lane_, r = lane_ & 31, h = lane_ >> 5;
    bf16_t* Q = (bf16_t*)(p.ws + WS_R + R_Q);
    const bf16_t* Kb = (const bf16_t*)(p.ws + WS_R + R_K);
    const bf16_t* Vt = (const bf16_t*)(p.ws + WS_R + R_VT);
    constexpr float LOG2E = 1.4426950408889634f;
    constexpr int ABUF = 49152, AKS = 0, AVS = 24576, AGL = 2 * ABUF;
    LAS float* gl = (LAS float*)(cx.lds + AGL);
    if (lane_ < HD) gl[lane_] = p.attn_q_gain[li * HD + lane_] * p.attn_k_gain[li * HD + lane_];
    if (lane_ < NQH) gl[64 + lane_] = p.attn_sinks[li * NQH + lane_] * 1.4426950408889634f;
    const int qtl = cx.wave >> 2, hl = cx.wave & 3;
    const int NU = NB * NKVH * (SEQ / 64);
    u32x4 Ak[3], Av[3], Bk[3], Bv[3], qpre[4];
#define ATT_PREFETCH_Q(u_) do { const int b_ = (u_) >> 7, kvh_ = ((u_) >> 5) & 3, kb_ = ((u_) & 31) * 64 - 128; \
        { const bf16_t* qp_ = Q + ((size_t)(b_ * SEQ + kb_ + 128 + 32 * qtl + r)) * 1024 + (kvh_ * 4 + hl) * 64 + 8 * h; _Pragma("unroll") for (int s_ = 0; s_ < 4; ++s_) qpre[s_] = *(const u32x4*)(qp_ + 16 * s_); } } while (0)
#define ATT_PREFETCH_KV(P_, u_) do { const int b_ = (u_) >> 7, kvh_ = ((u_) >> 5) & 3, kb_ = ((u_) & 31) * 64 - 128; \
        _Pragma("unroll") for (int j_ = 0; j_ < 3; ++j_) { const int idx = opaque_v(tid_) + 512 * j_; \
            { const int row = idx >> 3, c = idx & 7; int key = kb_ + row; key = key < 0 ? 0 : key; P_##k[j_] = *(const u32x4*)(Kb + ((size_t)(b_ * SEQ + key)) * 256 + kvh_ * 64 + 8 * c); } \
            { const int d = idx / 24, ch = idx % 24; int key0 = kb_ + 32 * (ch >> 2); key0 = key0 < 0 ? 0 : key0; P_##v[j_] = *(const u32x4*)(Vt + ((size_t)((b_ * 4 + kvh_) * 64 + d)) * 2048 + key0 + 8 * (ch & 3)); } } } while (0)
#define ATT_COMMIT(P_, buf_) do { LAS unsigned char* kb2 = cx.lds + (buf_) * ABUF + AKS; LAS unsigned char* vb2 = cx.lds + (buf_) * ABUF + AVS; \
        _Pragma("unroll") for (int j_ = 0; j_ < 3; ++j_) { const int idx = opaque_v(tid_) + 512 * j_; \
            { const int row = idx >> 3, c = idx & 7; float ss = ssq8(P_##k[j_]); ss += xor_swz<1>(ss); ss += xor_swz<2>(ss); ss += xor_swz<4>(ss); const float rk = rsqrtf(ss * (1.0f / HD) + RMS_EPS); u32x4 o; \
              o.x = cvt_pk_bf16(bf_lo(P_##k[j_].x) * rk, bf_hi(P_##k[j_].x) * rk); o.y = cvt_pk_bf16(bf_lo(P_##k[j_].y) * rk, bf_hi(P_##k[j_].y) * rk); o.z = cvt_pk_bf16(bf_lo(P_##k[j_].z) * rk, bf_hi(P_##k[j_].z) * rk); o.w = cvt_pk_bf16(bf_lo(P_##k[j_].w) * rk, bf_hi(P_##k[j_].w) * rk); \
              *(LAS u32x4*)(kb2 + row * 128 + ((c ^ ((row >> 1) & 7)) << 4)) = o; } \
            { const int d = idx / 24, ch = idx % 24; *(LAS u32x4*)(vb2 + d * 384 + ((ch ^ ((d >> 1) & 7)) << 4)) = P_##v[j_]; } } } while (0)
    int u = cx.vcu, buf = 0;
    if (u < NU) { ATT_PREFETCH_Q(u); ATT_PREFETCH_KV(A, u); ATT_COMMIT(A, 0); }
    if (u + cx.G < NU) ATT_PREFETCH_KV(B, u + cx.G);
    __syncthreads();
#define ATT_BODY(CUR_, NXT_, uu_) do { \
        const int b = (uu_) >> 7, kvh = ((uu_) >> 5) & 3, q0 = ((uu_) & 31) * 64 + 32 * qtl, hq = kvh * 4 + hl, kpos0 = q0 - 128; \
        const int kt0 = q0 >= 128 ? 0 : 4 - (q0 >> 5); \
        const bool has_next = ((uu_) + cx.G) < NU, has_next2 = ((uu_) + 2 * cx.G) < NU; \
        const LAS unsigned char* ks = cx.lds + buf * ABUF + AKS; const LAS unsigned char* vs = cx.lds + buf * ABUF + AVS; \
        bf16x8 bq[4]; \
        { \
            float ssq = 0.f; \
_Pragma("unroll") \
            for (int s_ = 0; s_ < 4; ++s_) ssq += ssq8(qpre[s_]); \
            ssq = half_sum(ssq); \
            const float rq = rsqrtf(ssq * (1.0f / HD) + RMS_EPS) * (0.125f * LOG2E); \
            f32x4 gqk[4][2]; \
_Pragma("unroll") \
            for (int s_ = 0; s_ < 4; ++s_) { gqk[s_][0] = *(const LAS f32x4*)(gl + 16 * s_ + 8 * h); gqk[s_][1] = *(const LAS f32x4*)(gl + 16 * s_ + 8 * h + 4); } \
_Pragma("unroll") \
            for (int s_ = 0; s_ < 4; ++s_) { u32x4 o; \
                o.x = cvt_pk_bf16(bf_lo(qpre[s_].x) * rq * gqk[s_][0][0], bf_hi(qpre[s_].x) * rq * gqk[s_][0][1]); o.y = cvt_pk_bf16(bf_lo(qpre[s_].y) * rq * gqk[s_][0][2], bf_hi(qpre[s_].y) * rq * gqk[s_][0][3]); \
                o.z = cvt_pk_bf16(bf_lo(qpre[s_].z) * rq * gqk[s_][1][0], bf_hi(qpre[s_].z) * rq * gqk[s_][1][1]); o.w = cvt_pk_bf16(bf_lo(qpre[s_].w) * rq * gqk[s_][1][2], bf_hi(qpre[s_].w) * rq * gqk[s_][1][3]); \
                bq[s_] = __builtin_bit_cast(bf16x8, o); } \
        } \
        if (has_next) ATT_PREFETCH_Q((uu_) + cx.G); \
        if (has_next2) ATT_PREFETCH_KV(CUR_, (uu_) + 2 * cx.G); \
        f32x16 st[5]; \
        bf16x8 kfr[2][4]; \
_Pragma("unroll") \
        for (int s_ = 0; s_ < 4; ++s_) { const int row = 32 * qtl + r; kfr[0][s_] = *(const LAS bf16x8*)(ks + row * 128 + (((2 * s_ + h) ^ ((row >> 1) & 7)) << 4)); } \
_Pragma("unroll") \
        for (int kt = 0; kt < 5; ++kt) { \
            __builtin_amdgcn_sched_barrier(0); \
            if (kt < 4) { \
_Pragma("unroll") \
                for (int s_ = 0; s_ < 4; ++s_) { const int row = 32 * (qtl + kt + 1) + r; kfr[(kt + 1) & 1][s_] = *(const LAS bf16x8*)(ks + row * 128 + (((2 * s_ + h) ^ ((row >> 1) & 7)) << 4)); } } \
            __builtin_amdgcn_sched_barrier(0); \
            f32x16 acc; \
_Pragma("unroll") \
            for (int e = 0; e < 16; ++e) acc[e] = 0.f; \
_Pragma("unroll") \
            for (int s_ = 0; s_ < 4; ++s_) acc = __builtin_amdgcn_mfma_f32_32x32x16_bf16(kfr[kt & 1][s_], bq[s_], acc, 0, 0, 0); \
_Pragma("unroll") \
            for (int e = 0; e < 16; ++e) { \
                const int row0 = (e & 3) + 8 * (e >> 2); \
                float v = acc[e]; \
                if (kt == 0) v = (row0 + 4 * h >= r + 1) ? v : -INFINITY; \
                if (kt == 4) v = (row0 + 4 * h <= r) ? v : -INFINITY; \
                acc[e] = v; \
            } \
            if (kt < 4 && kt < kt0) { \
_Pragma("unroll") \
                for (int e = 0; e < 16; ++e) acc[e] = -INFINITY; } \
            st[kt] = acc; \
        } \
        const float sink2 = gl[64 + hq]; \
        float m = sink2; \
_Pragma("unroll") \
        for (int kt = 0; kt < 5; ++kt) \
_Pragma("unroll") \
            for (int e = 0; e < 16; ++e) m = fmaxf(m, st[kt][e]); \
        m = half_max(m); \
        float lsum = 0.f; \
        f32x16 o0, o1; \
_Pragma("unroll") \
        for (int e = 0; e < 16; ++e) { o0[e] = 0.f; o1[e] = 0.f; } \
        bf16x8 vfr[2][4]; \
_Pragma("unroll") \
        for (int s_ = 0; s_ < 2; ++s_) { const int ch = 4 * qtl + 2 * h + s_; \
            vfr[0][2 * s_] = *(const LAS bf16x8*)(vs + r * 384 + ((ch ^ ((r >> 1) & 7)) << 4)); vfr[0][2 * s_ + 1] = *(const LAS bf16x8*)(vs + (32 + r) * 384 + ((ch ^ (((32 + r) >> 1) & 7)) << 4)); } \
_Pragma("unroll") \
        for (int kt = 0; kt < 5; ++kt) { \
            __builtin_amdgcn_sched_barrier(0); \
            if (kt < 4) { \
_Pragma("unroll") \
                for (int s_ = 0; s_ < 2; ++s_) { const int ch = 4 * (qtl + kt + 1) + 2 * h + s_; \
                    vfr[(kt + 1) & 1][2 * s_] = *(const LAS bf16x8*)(vs + r * 384 + ((ch ^ ((r >> 1) & 7)) << 4)); vfr[(kt + 1) & 1][2 * s_ + 1] = *(const LAS bf16x8*)(vs + (32 + r) * 384 + ((ch ^ (((32 + r) >> 1) & 7)) << 4)); } } \
            __builtin_amdgcn_sched_barrier(0); \
_Pragma("unroll") \
            for (int e = 0; e < 16; ++e) { const float pv = __builtin_amdgcn_exp2f(st[kt][e] - m); st[kt][e] = pv; lsum += pv; } \
_Pragma("unroll") \
            for (int s_ = 0; s_ < 2; ++s_) { \
                u32x4 pw; \
                pw.x = cvt_pk_bf16(st[kt][8 * s_ + 0], st[kt][8 * s_ + 1]); pw.y = cvt_pk_bf16(st[kt][8 * s_ + 2], st[kt][8 * s_ + 3]); \
                pw.z = cvt_pk_bf16(st[kt][8 * s_ + 4], st[kt][8 * s_ + 5]); pw.w = cvt_pk_bf16(st[kt][8 * s_ + 6], st[kt][8 * s_ + 7]); \
                o0 = __builtin_amdgcn_mfma_f32_32x32x16_bf16(vfr[kt & 1][2 * s_], __builtin_bit_cast(bf16x8, pw), o0, 0, 0, 0); \
                o1 = __builtin_amdgcn_mfma_f32_32x32x16_bf16(vfr[kt & 1][2 * s_ + 1], __builtin_bit_cast(bf16x8, pw), o1, 0, 0, 0); \
            } \
        } \
        lsum = half_sum(lsum) + __builtin_amdgcn_exp2f(sink2 - m); \
        const float inv = 1.0f / lsum; \
        unsigned char* op = Odst + ((size_t)(b * SEQ + q0 + r)) * 1024 + hq * 64 + 4 * h; \
        const float inv16 = inv * 16.f; \
_Pragma("unroll") \
        for (int g4 = 0; g4 < 4; ++g4) { \
            *(unsigned*)(op + 8 * g4) = pack4_fp8_raw(o0[4 * g4 + 0] * inv16, o0[4 * g4 + 1] * inv16, o0[4 * g4 + 2] * inv16, o0[4 * g4 + 3] * inv16); \
            *(unsigned*)(op + 32 + 8 * g4) = pack4_fp8_raw(o1[4 * g4 + 0] * inv16, o1[4 * g4 + 1] * inv16, o1[4 * g4 + 2] * inv16, o1[4 * g4 + 3] * inv16); \
        } \
        if (has_next) ATT_COMMIT(NXT_, buf ^ 1); \
    } while (0)
    for (; u < NU; u += 2 * cx.G) {
        ATT_BODY(A, B, u);
        __syncthreads();
        buf ^= 1;
        if (u + cx.G >= NU) break;
        ATT_BODY(B, A, u + cx.G);
        __syncthreads();
        buf ^= 1;
    }
#undef ATT_BODY
#undef ATT_PREFETCH_Q
#undef ATT_PREFETCH_KV
#undef ATT_COMMIT
}

__device__ __forceinline__ void phase_ssm_scan(const Params& p, const Ctx& cx, int si) {
    const int lane_ = opaque_v(lane_id());
    const float* abar = (const float*)(p.ws + WS_SSMP);
    const unsigned* Wst = (const unsigned*)(p.ws + WS_R + R_W);
    unsigned* US = (unsigned*)(p.ws + WS_R + R_US);
    for (int w = cx.wave; ; w += NWAVES) {
        const int L = (w >> 1) * cx.G + cx.vcu; if (L >= SG * 8) break;
        const int it = 2 * L + (w & 1);
        const int g = it >> 4, b = it & 15, gi = (si * 64 + g) * 64 + lane_;
        float ar = abar[gi * 2], ai = abar[gi * 2 + 1];
#pragma unroll
        for (int q = 0; q < 4; ++q) { const float nr = ar * ar - ai * ai, ni = 2.0f * ar * ai; ar = nr; ai = ni; }
        const size_t row0 = (size_t)g * 2048 + b * 128;
        float sr = 0.f, si_ = 0.f;
        const unsigned* wp = Wst + row0 * 64 + lane_;
        unsigned* up = US + row0 * 192 + 128 + lane_;
        unsigned wA[16], wB[16];
#define SCAN_LOAD(w_, k0_) do { _Pragma("unroll") for (int q = 0; q < 16; ++q) w_[q] = wp[(size_t)((k0_) + q) * 64]; } while (0)
#define SCAN_STEPS(w_, k0_) do { _Pragma("unroll") for (int q = 0; q < 16; ++q) { \
            up[(size_t)((k0_) + q) * 192] = cvt_pk_bf16(sr, si_); \
            const float wr_ = bf_lo(w_[q]), wi_ = bf_hi(w_[q]); \
            const float nr = ar * sr - ai * si_ + wr_, ni = ar * si_ + ai * sr + wi_; sr = nr; si_ = ni; } } while (0)
        SCAN_LOAD(wA, 0);
#pragma unroll 1
        for (int k0 = 0; k0 < 128; k0 += 32) {
            SCAN_LOAD(wB, k0 + 16);
            SCAN_STEPS(wA, k0);
            if (k0 + 32 < 128) SCAN_LOAD(wA, k0 + 32);
            SCAN_STEPS(wB, k0 + 16);
        }
#undef SCAN_LOAD
#undef SCAN_STEPS
    }
}

__device__ __forceinline__ void moe_tail_convert(const Params& p, const Ctx& cx, int ctr_id, int ibeg, int iend) {
    const int lane2 = opaque_v(lane_id()), tid2 = cx.wave * 64 + lane2, ibase = ibeg, nit = iend - ibeg;
    constexpr int CH = 2; const int nch = (nit + CH - 1) / CH;
    unsigned* ctr = (unsigned*)(p.ws + WS_CTL) + CW_CONV + ctr_id * 64;
    volatile LAS unsigned* slot = (volatile LAS unsigned*)(cx.lds + MISC_OFF) + 100;
    unsigned cur = *slot;
    if (cur == 0xffffffffu) {
        __syncthreads();
        if (tid2 == 0) *slot = __hip_atomic_fetch_add(ctr, 1u, __ATOMIC_RELAXED, __HIP_MEMORY_SCOPE_AGENT);
        __syncthreads();
        cur = *slot;
    }
    while (cur < (unsigned)nch) {
        unsigned nxt = 0;
        if (tid2 == 0) nxt = __hip_atomic_fetch_add(ctr, 1u, __ATOMIC_RELAXED, __HIP_MEMORY_SCOPE_AGENT);
        { const int cb = (int)cur * CH; int ce = cb + CH; if (ce > nit) ce = nit; conv_range(p, cx, tid2, ibase + cb, ibase + ce); }
        if (tid2 == 0) *slot = nxt;
        __syncthreads();
        cur = *slot;
    }
}

__global__ void __launch_bounds__(NWAVES * 64, 2) fwd(Params p_unused) {
    extern __shared__ __attribute__((aligned(16))) unsigned char lds_raw[];
    Ctx cx;
    cx.lds = (LAS unsigned char*)lds_raw;
    const int tid0 = threadIdx.x; cx.wave = __builtin_amdgcn_readfirstlane(tid0 >> 6);
    cx.G = gridDim.x; { const int bx = blockIdx.x; cx.vcu = (cx.G % 8 == 0) ? (bx % 8) * (cx.G / 8) + bx / 8 : bx; }
    cx.gw = cx.vcu * NWAVES + cx.wave; cx.NGW = cx.G * NWAVES;
    unsigned* ctl; { const Params p = load_params(); ctl = (unsigned*)(p.ws + WS_CTL); }
    volatile LAS unsigned* MISC = (volatile LAS unsigned*)(cx.lds + MISC_OFF);
    for (int u = tid0; u < (LDS_BYTES - MISC_OFF) / 4; u += NWAVES * 64) ((LAS unsigned*)(cx.lds + MISC_OFF))[u] = 0u;
    __syncthreads();
    XcdBarrier bar = xcd_barrier_post((gu32*)ctl + CW_BAR, MISC + 8);
#define GRID_BAR() xcd_barrier<false>(bar, cx.wave)

    { const Params p = load_params(); phase_p0(p, cx); __syncthreads(); }
    xcd_barrier<true>(bar, cx.wave);

    for (int l = 0; l < DEPTH; ++l) {
        {
            const Params p = load_params();
            const float* g2l = (const float*)(p.ws + WS_ADA) + (size_t)(l - 1) * 16 * ADA + 5120;
            if (l == 0) phase_n1<0>(p, cx, 0, g2l); else phase_n1<1>(p, cx, l, g2l);
        }
        GRID_BAR();
        const int li = l >> 1;
        if ((l & 1) == 0) {
            {
                const Params p = load_params(); const bf16_t* H = (const bf16_t*)((const char*)p.out + OUT_H);
                pg8::DenseOrder S; S.init(NTOK, QKVD, DM / 2, DM / 2, cx.G, (int)blockIdx.x, H, (const bf16_t*)(p.ws + WS_WATT + (size_t)li * 5 * MiB));
                S.via_table = true;
                EpiQKV E{(bf16_t*)(p.ws + WS_R + R_Q), (bf16_t*)(p.ws + WS_R + R_K), (bf16_t*)(p.ws + WS_R + R_VT)};
                pg8::gemm_phase<EpiQKV, pg8::DenseOrder, true, true, true, true>(cx.lds, cx.wave, DM / 2, DM / 2, S, E, (volatile LAS const unsigned*)(cx.lds + MOE_TAB + 256));
            }
            GRID_BAR();
            { const Params p = load_params();
                {
                    const float* gl = (const float*)(p.ws + WS_ADA) + (size_t)l * 16 * ADA + 2048;
                    pg8::DenseOrder S; S.init(NTOK, DM, DM / 2, DM / 2, cx.G, (int)blockIdx.x, nullptr, nullptr); S.via_table = true;
                    const int lane2 = opaque_v(lane_id()), tid2 = cx.wave * 64 + lane2; LAS float* gt = (LAS float*)(cx.lds + MOE_TAB);
                    pg8::Unit uu; for (int i = 0; i < MAXU && S.next(i, uu); ++i) if (tid2 < 256) gt[i * 256 + tid2] = gl[(size_t)(uu.pm >> 3) * ADA + uu.pn * 256 + tid2];
                }
                phase_attn(p, cx, li, p.ws + WS_R + R_O8); }
            GRID_BAR();
            {
                const Params p = load_params();
                const float* gl = (const float*)(p.ws + WS_ADA) + (size_t)l * 16 * ADA + 2048;
                pg8::DenseOrder S; S.init(NTOK, DM, DM / 2, DM / 2, cx.G, (int)blockIdx.x, (const bf16_t*)(p.ws + WS_R + R_O8), (const bf16_t*)(p.ws + WS_WATT + (size_t)li * 5 * MiB + 3 * MiB));
                S.via_table = true;
                EpiDelta E{(bf16_t*)(p.ws + WS_D), gl};
                pg8::gemm_phase<EpiDelta, pg8::DenseOrder, true, true, true, true>(cx.lds, cx.wave, DM / 2, DM / 2, S, E, (volatile LAS const unsigned*)(cx.lds + MOE_TAB + 256));
            }
            GRID_BAR();
        } else {
            {
                const Params p = load_params(); const bf16_t* H = (const bf16_t*)((const char*)p.out + OUT_H);
                pg8::DenseOrder S; S.init(NTOK, DM, DM / 2, DM / 2, cx.G, (int)blockIdx.x, H, (const bf16_t*)(p.ws + WS_WSSM + (size_t)li * 6 * MiB));
                S.via_table = true;
                EpiU E{(bf16_t*)(p.ws + WS_R + R_US)};
                pg8::gemm_phase<EpiU, pg8::DenseOrder, true, true, true, true>(cx.lds, cx.wave, DM / 2, DM / 2, S, E, (volatile LAS const unsigned*)(cx.lds + MOE_TAB + 256));
            }
            GRID_BAR();
            {
                const Params p = load_params();
                {
                    const float* gl = (const float*)(p.ws + WS_ADA) + (size_t)l * 16 * ADA + 2048;
                    pg8::DenseOrder S; S.init(NTOK, 2 * DM, DM / 2, DM / 2, cx.G, (int)blockIdx.x, nullptr, nullptr); S.via_table = true;
                    const int lane2 = opaque_v(lane_id()), tid2 = cx.wave * 64 + lane2; LAS float* gt = (LAS float*)(cx.lds + MOE_TAB);
                    pg8::Unit uu; for (int i = 0; i < MAXU && S.next(i, uu); ++i) if (tid2 < 128) gt[i * 256 + tid2] = gl[(size_t)(uu.pm >> 3) * ADA + uu.pn * 128 + tid2];
                }
                SsmOrder S{cx.G, cx.vcu, 256, (const bf16_t*)(p.ws + WS_R + R_US), (const bf16_t*)(p.ws + WS_SSMM + (size_t)li * 20 * MiB + 12 * MiB), (size_t)256 * 256};
                EpiW E{(bf16_t*)(p.ws + WS_R + R_W)};
                pg8::gemm_phase<EpiW, SsmOrder, false, true>(cx.lds, cx.wave, 256, 384, S, E, nullptr);
            }
            asm volatile("s_waitcnt vmcnt(0)" ::: "memory"); __builtin_amdgcn_fence(__ATOMIC_RELEASE, "workgroup"); __syncthreads(); __builtin_amdgcn_fence(__ATOMIC_ACQUIRE, "workgroup");
            { const Params p = load_params(); phase_ssm_scan(p, cx, li); }
            asm volatile("s_waitcnt vmcnt(0)" ::: "memory"); __builtin_amdgcn_fence(__ATOMIC_RELEASE, "workgroup"); __syncthreads(); __builtin_amdgcn_fence(__ATOMIC_ACQUIRE, "workgroup");
            {
                const Params p = load_params();
                SsmOrder S{cx.G, cx.vcu, 384, (const bf16_t*)(p.ws + WS_R + R_US), (const bf16_t*)(p.ws + WS_SSMM + (size_t)li * 20 * MiB), (size_t)256 * 384};
                EpiY E{(bf16_t*)(p.ws + WS_R + R_YG)};
                pg8::gemm_phase<EpiY, SsmOrder, false, true>(cx.lds, cx.wave, 384, 384, S, E, nullptr);
            }
            GRID_BAR();
            {
                const Params p = load_params();
                const float* gl = (const float*)(p.ws + WS_ADA) + (size_t)l * 16 * ADA + 2048;
                pg8::DenseOrder S; S.init(NTOK, 2 * DM, DM / 2, DM / 2, cx.G, (int)blockIdx.x, (const bf16_t*)(p.ws + WS_R + R_YG), (const bf16_t*)(p.ws + WS_WSSM + (size_t)li * 6 * MiB + 2 * MiB));
                EpiGLU E{(bf16_t*)(p.ws + WS_D), gl};
                S.via_table = true;
                pg8::gemm_phase<EpiGLU, pg8::DenseOrder, true, true, true, true>(cx.lds, cx.wave, DM / 2, DM / 2, S, E, (volatile LAS const unsigned*)(cx.lds + MOE_TAB + 256));
            }
            GRID_BAR();
        }
        { const Params p = load_params(); phase_n2(p, cx, l, l); }
        GRID_BAR();
        {
            const Params p = load_params(); const bf16_t* H = (const bf16_t*)((const char*)p.out + OUT_H);
            const int nu = moe_setup<2, false>(p, cx, l, CONV_IN_TAIL ? l : -1);
            MoeOrder S{(LAS const int*)(cx.lds + MOE_TAB), nu, DM / 2, 0, H, (const bf16_t*)(p.ws + WS_WMOE + (size_t)l * NE * 3 * MiB / 2), 0};
            EpiSwiGLU E{(bf16_t*)((char*)p.out + OUT_HID)};
            pg8::gemm_phase<EpiSwiGLU, MoeOrder, true, true, true>(cx.lds, cx.wave, DM / 2, DM / 2, S, E, (volatile LAS const unsigned*)(cx.lds + MOE_TAB + 256));
            if (CONV_IN_TAIL) { __syncthreads();
                const int ib = CI_DENSE + l * NE * CI_EXP + NE * 32, ie = CI_DENSE + (l + 1) * NE * CI_EXP + ((l + 1 < DEPTH) ? GU_E1 : 0); moe_tail_convert(p, cx, l, ib, ie); }
        }
        GRID_BAR();
        {
            const Params p = load_params();
            const int nu = moe_setup<4, true>(p, cx, l, (CONV_IN_TAIL && l + 1 < DEPTH) ? 4 + l : -1);
            MoeOrder S{(LAS const int*)(cx.lds + MOE_TAB), nu, FE / 2, 0, (const bf16_t*)((const char*)p.out + OUT_HID), (const bf16_t*)(p.ws + WS_WMOE + (size_t)l * NE * 3 * MiB / 2), (size_t)(MiB / 2)};
            EpiDown E{(bf16_t*)(p.ws + WS_R + R_Y)};
            pg8::gemm_phase<EpiDown, MoeOrder, true, true, true, true>(cx.lds, cx.wave, FE / 2, FE / 2, S, E, (volatile LAS const unsigned*)(cx.lds + MOE_TAB + 256 + MAXU * 256 * 8));
            if (CONV_IN_TAIL && l + 1 < DEPTH) { __syncthreads(); const int ib = CI_DENSE + (l + 1) * NE * CI_EXP + GU_E1, ie = CI_DENSE + (l + 1) * NE * CI_EXP + NE * 32; moe_tail_convert(p, cx, 4 + l, ib, ie); }
        }
        GRID_BAR();
    }
    { const Params p = load_params(); phase_n1<2>(p, cx, DEPTH, (const float*)(p.ws + WS_ADA) + (size_t)(DEPTH - 1) * 16 * ADA + 5120); }
}

extern "C" void kernel_launch(void* const* d_in, const int* in_sizes, int n_in, void* d_out, int out_size, void* d_ws, size_t ws_size, hipStream_t stream) {
    static int grid = 0;
    if (grid == 0) {
        if (n_in != 28 || out_size != NTOK * DM || ws_size < WS_END) { fprintf(stderr, "kernel_launch: unexpected problem (n_in %d, out %d, ws %zu < %zu); nothing launched\n", n_in, out_size, ws_size, (size_t)WS_END); grid = -1; return; }
        int dev = 0, cus = 0, per_cu = 0;
        if (hipGetDevice(&dev) != hipSuccess || hipDeviceGetAttribute(&cus, hipDeviceAttributeMultiprocessorCount, dev) != hipSuccess) { grid = -1; return; }
        if (hipFuncSetAttribute((const void*)fwd, hipFuncAttributeMaxDynamicSharedMemorySize, LDS_BYTES) != hipSuccess) { fprintf(stderr, "kernel_launch: hipFuncSetAttribute failed\n"); grid = -1; return; }
        if (hipOccupancyMaxActiveBlocksPerMultiprocessor(&per_cu, (const void*)fwd, NWAVES * 64, LDS_BYTES) != hipSuccess || per_cu < 1)
            fprintf(stderr, "kernel_launch: note: occupancy query reports %d workgroups per CU\n", per_cu);
        (void)hipGetLastError();
        grid = cus;
    }
    if (grid < 0) return;
    if (hipMemsetAsync((char*)d_ws + WS_CTL, 0, CTL_ZERO_BYTES, stream) != hipSuccess) return;
    Params p{};
    const float** pf = (const float**)&p;
    for (int i = 0; i < 28; ++i) pf[i] = (const float*)d_in[i];
    p.out = (float*)d_out; p.ws = (unsigned char*)d_ws;
    hipLaunchKernelGGL(fwd, dim3(grid), dim3(NWAVES * 64), LDS_BYTES, stream, p);
}
```
